# Optimizing an MI355X kernel written in HIP

```python
import jax, jax.numpy as jnp
from jax import lax
import numpy as np

D_MODEL = 1024
BATCH = 2
SEQ = 16384
DEPTH = 4

N_A_LAYERS = DEPTH // 2
N_B_LAYERS = DEPTH - N_A_LAYERS
POOL_WINDOWS = (2, 4, 8, 16)
N_POOL_GROUPS = len(POOL_WINDOWS)
POOL_GROUP = D_MODEL // N_POOL_GROUPS
HEAD_DIM = 64
N_HEADS = D_MODEL // HEAD_DIM
N_KV_HEADS = 4
GQA_GROUP = N_HEADS // N_KV_HEADS
WINDOW = 128
BLOCK = 128
ROPE_THETA = 10000.0
D_FF = ((8 * D_MODEL + 3 * 256 - 1) // (3 * 256)) * 256
PLE_DIM = 256
RMS_EPS = 1e-6
NEG_INF = -1e30

kernel_name = "yoco_pool_swa_sink_hybrid"


def rms_norm(x, g):
    xf = x.astype(jnp.float32)
    y = xf * lax.rsqrt(jnp.mean(xf * xf, axis=-1, keepdims=True) + RMS_EPS)
    return (y * g.astype(jnp.float32)).astype(x.dtype)


def rope_tables(seq):
    inv = 1.0 / (ROPE_THETA ** (jnp.arange(0, HEAD_DIM, 2, dtype=jnp.float32) / HEAD_DIM))
    ang = jnp.arange(seq, dtype=jnp.float32)[:, None] * inv[None, :]
    return jnp.cos(ang), jnp.sin(ang)


def apply_rope(x, cos, sin):
    xf = x.astype(jnp.float32)
    half = HEAD_DIM // 2
    x1, x2 = xf[..., :half], xf[..., half:]
    c = cos[None, :, None, :]
    s = sin[None, :, None, :]
    return jnp.concatenate([x1 * c - x2 * s, x2 * c + x1 * s], axis=-1).astype(x.dtype)


def multiscale_pool(x, w_pool, pool_scale):
    b, s, _ = x.shape
    xf = x.astype(jnp.float32).reshape(b, s, N_POOL_GROUPS, POOL_GROUP)
    cs = jnp.cumsum(xf, axis=1)
    t = jnp.arange(s)
    pooled = []
    for g, w in enumerate(POOL_WINDOWS):
        csg = cs[:, :, g]
        lower = jnp.concatenate([jnp.zeros((b, w, POOL_GROUP), jnp.float32), csg[:, :s - w]], axis=1)
        cnt = jnp.minimum(t + 1, w).astype(jnp.float32)[None, :, None]
        pooled.append((csg - lower) / cnt - xf[:, :, g])
    pooled = jnp.stack(pooled, axis=2).astype(x.dtype)
    y = jnp.einsum('bsgc,gcd->bsgd', pooled, w_pool).reshape(b, s, D_MODEL)
    return y * pool_scale


def sliding_window_sink_attention(q, k, v, sinks):
    b, s = q.shape[0], q.shape[1]
    nb = s // BLOCK
    qb = q.reshape(b, nb, BLOCK, N_KV_HEADS, GQA_GROUP, HEAD_DIM)

    def band(t):
        tb = t.reshape(b, nb, BLOCK, N_KV_HEADS, HEAD_DIM)
        prev = jnp.concatenate([jnp.zeros_like(tb[:, :1]), tb[:, :-1]], axis=1)
        return jnp.concatenate([prev, tb], axis=2)

    kb, vb = band(k), band(v)
    scores = jnp.einsum('bnqkgd,bnskd->bnkgqs', qb, kb).astype(jnp.float32) * (HEAD_DIM ** -0.5)
    blk = jnp.arange(nb)[:, None, None] * BLOCK
    qpos = blk + jnp.arange(BLOCK)[None, :, None]
    kpos = blk - BLOCK + jnp.arange(2 * BLOCK)[None, None, :]
    diff = qpos - kpos
    valid = (diff >= 0) & (diff < WINDOW) & (kpos >= 0)
    scores = jnp.where(valid[None, :, None, None], scores, NEG_INF)
    sink = sinks.astype(jnp.float32).reshape(N_KV_HEADS, GQA_GROUP)[None, None, :, :, None, None]
    sink = jnp.broadcast_to(sink, scores.shape[:-1] + (1,))
    probs = jax.nn.softmax(jnp.concatenate([scores, sink], axis=-1), axis=-1)[..., :-1]
    out = jnp.einsum('bnkgqs,bnskd->bnqkgd', probs.astype(v.dtype), vb)
    return out.reshape(b, s, N_HEADS * HEAD_DIM)


def swiglu(x, w_gate, w_up, w_down):
    return (jax.nn.silu(x @ w_gate) * (x @ w_up)) @ w_down


def setup_inputs(seed: int = 0) -> dict:
    key = jax.random.key(seed)
    ks = jax.random.split(key, 20)
    f32 = jnp.float32

    def nrm(k, shape, fan_in):
        return jax.random.normal(k, shape, f32) * (fan_in ** -0.5)

    def gain(k, shape):
        return 1.0 + 0.05 * jax.random.normal(k, shape, f32)

    return {
        "x": jax.random.normal(ks[0], (BATCH, SEQ, D_MODEL), f32),
        "p": jax.random.normal(ks[1], (DEPTH, BATCH, SEQ, PLE_DIM), f32),
        "mix_pre_g": gain(ks[2], (DEPTH, D_MODEL)),
        "mix_post_g": gain(ks[3], (DEPTH, D_MODEL)),
        "ffn_pre_g": gain(ks[4], (DEPTH, D_MODEL)),
        "ffn_post_g": gain(ks[5], (DEPTH, D_MODEL)),
        "pool_w": nrm(ks[6], (N_A_LAYERS, N_POOL_GROUPS, POOL_GROUP, POOL_GROUP), POOL_GROUP),
        "pool_scale": 1.0 + 0.1 * jax.random.normal(ks[7], (N_A_LAYERS, D_MODEL), f32),
        "kv_norm_g": gain(ks[8], (D_MODEL,)),
        "w_k": nrm(ks[9], (D_MODEL, N_KV_HEADS * HEAD_DIM), D_MODEL),
        "w_v": nrm(ks[10], (D_MODEL, N_KV_HEADS * HEAD_DIM), D_MODEL),
        "w_q": nrm(ks[11], (N_B_LAYERS, D_MODEL, N_HEADS * HEAD_DIM), D_MODEL),
        "w_o": nrm(ks[12], (N_B_LAYERS, N_HEADS * HEAD_DIM, D_MODEL), N_HEADS * HEAD_DIM),
        "sinks": 0.5 * jax.random.normal(ks[13], (N_B_LAYERS, N_HEADS), f32),
        "w_ff_gate": nrm(ks[14], (DEPTH, D_MODEL, D_FF), D_MODEL),
        "w_ff_up": nrm(ks[15], (DEPTH, D_MODEL, D_FF), D_MODEL),
        "w_ff_down": nrm(ks[16], (DEPTH, D_FF, D_MODEL), D_FF),
        "ple_norm_g": gain(ks[17], (DEPTH, D_MODEL)),
        "w_ple_gate": nrm(ks[18], (DEPTH, D_MODEL, D_MODEL), D_MODEL),
        "w_ple_proj": nrm(ks[19], (DEPTH, PLE_DIM, D_MODEL), PLE_DIM),
    }


def reference(x, p, mix_pre_g, mix_post_g, ffn_pre_g, ffn_post_g, pool_w, pool_scale,
              kv_norm_g, w_k, w_v, w_q, w_o, sinks, w_ff_gate, w_ff_up, w_ff_down,
              ple_norm_g, w_ple_gate, w_ple_proj):
    b, s, _ = x.shape
    cos, sin = rope_tables(s)
    h = x
    k_shared = None
    v_shared = None
    for i in range(DEPTH):
        hn = rms_norm(h, mix_pre_g[i])
        if i < N_A_LAYERS:
            m = multiscale_pool(hn, pool_w[i], pool_scale[i])
        else:
            j = i - N_A_LAYERS
            q = apply_rope((hn @ w_q[j]).reshape(b, s, N_HEADS, HEAD_DIM), cos, sin)
            m = sliding_window_sink_attention(q, k_shared, v_shared, sinks[j]) @ w_o[j]
        h = h + rms_norm(m, mix_post_g[i])
        f = swiglu(rms_norm(h, ffn_pre_g[i]), w_ff_gate[i], w_ff_up[i], w_ff_down[i])
        h = h + rms_norm(f, ffn_post_g[i])
        gate = jax.nn.sigmoid(rms_norm(h, ple_norm_g[i]) @ w_ple_gate[i])
        h = h + (p[i] @ w_ple_proj[i]) * gate
        if i == N_A_LAYERS - 1:
            hk = rms_norm(h, kv_norm_g)
            k_shared = apply_rope((hk @ w_k).reshape(b, s, N_KV_HEADS, HEAD_DIM), cos, sin)
            v_shared = (hk @ w_v).reshape(b, s, N_KV_HEADS, HEAD_DIM)
    return h
```

```cpp
#include <hip/hip_runtime.h>
#include <hip/hip_cooperative_groups.h>
#include <cstdint>
#include <cstdio>
namespace cg = cooperative_groups;

#define LAS __attribute__((address_space(3)))
#define GAS __attribute__((address_space(1)))
typedef unsigned short bf16_t;
typedef short bf16x8 __attribute__((ext_vector_type(8)));
typedef short s16x4 __attribute__((ext_vector_type(4)));
typedef float f32x4 __attribute__((ext_vector_type(4)));
typedef float f32x2 __attribute__((ext_vector_type(2)));
typedef float f32x16 __attribute__((ext_vector_type(16)));
typedef unsigned u32x4 __attribute__((ext_vector_type(4)));
typedef unsigned u32x2 __attribute__((ext_vector_type(2)));

constexpr int T = 32768, SEQ = 16384, D = 1024, FF = 2816, PLE = 256;
constexpr float EPS = 1e-6f;
constexpr float LOG2E = 1.4426950408889634f;
constexpr float C2 = 0.125f * LOG2E;
constexpr int NWAVES = 8, NTHREADS = 512;

constexpr size_t MiB = 1u << 20;
constexpr size_t WS_W = 0;
constexpr size_t WS_HB = 88 * MiB;
constexpr size_t WS_MB = 152 * MiB;
constexpr size_t WS_ACT = 216 * MiB;
constexpr size_t WS_K = 392 * MiB, WS_V = 408 * MiB, WS_PB = 424 * MiB;
constexpr size_t WS_COS = 440 * MiB, WS_SIN = 442 * MiB, WS_PSSA = 444 * MiB, WS_PSSB = 446 * MiB, WS_PP = 448 * MiB, WS_END = 512 * MiB;
constexpr size_t WS_BAR = 86 * MiB;
constexpr size_t WS_XS = 87 * MiB;
constexpr size_t BAR_ZERO_BYTES = 65536;
constexpr size_t W_GU = 0, W_GU_SZ = (size_t)2 * FF * D;
constexpr size_t W_D = W_GU + 4 * W_GU_SZ, W_D_SZ = (size_t)D * FF;
constexpr size_t W_PG = W_D + 4 * W_D_SZ, W_PG_SZ = (size_t)D * D;
constexpr size_t W_PP = W_PG + 4 * W_PG_SZ, W_PP_SZ = (size_t)D * PLE;
constexpr size_t W_POOL = W_PP + 4 * W_PP_SZ, W_POOL_SZ = (size_t)D * 256;
constexpr size_t W_QKV = W_POOL + 2 * W_POOL_SZ, W_QKV_SZ = (size_t)1536 * D;
constexpr size_t W_Q3 = W_QKV + W_QKV_SZ;
constexpr size_t W_O = W_Q3 + (size_t)D * D;
constexpr size_t W_END = W_O + 2 * (size_t)D * D;
static_assert(W_END * 2 <= WS_BAR, "weights fit");

constexpr int LDS_BYTES = 147456;

typedef __bf16 bf16x2_t __attribute__((ext_vector_type(2)));
__device__ __forceinline__ unsigned cvt_pk_bf16(float lo, float hi) { const f32x2 v = {lo, hi}; const bf16x2_t b = __builtin_convertvector(v, bf16x2_t); return __builtin_bit_cast(unsigned, b); }
__device__ __forceinline__ float bf_lo(unsigned w) { return __uint_as_float(w << 16); }
__device__ __forceinline__ float bf_hi(unsigned w) { return __uint_as_float(w & 0xffff0000u); }
__device__ __forceinline__ float shx(float v, int mask, int lane) { return __int_as_float(__builtin_amdgcn_ds_bpermute((lane ^ mask) << 2, __float_as_int(v))); }
__device__ __forceinline__ float wave_sum(float v, int lane) {
#pragma unroll
    for (int o = 1; o < 64; o <<= 1) v += shx(v, o, lane);
    return v;
}
__device__ __forceinline__ float sigmoid_f(float v) { return __builtin_amdgcn_rcpf(1.0f + __expf(-v)); }

namespace pg8 {
constexpr int BM = 256, BK = 64, HALF = 128, HTB = HALF * BK * 2, STAGE_BYTES = 8 * HTB, NXCD = 8, WGM = 8;
__device__ __forceinline__ int lds_byte(int r, int c) { const int st = (r >> 4) * 2 + (c >> 5), rr = r & 15, cc = c & 31, ob = rr * 64 + cc * 2; return st * 1024 + (ob ^ (((ob >> 9) & 1) << 5)); }
__device__ __forceinline__ void stage_rc(int b, int& R, int& C) { const int st = b / 1024, sb = b % 1024, swz = sb ^ (((sb >> 9) & 1) << 5); R = (st >> 1) * 16 + swz / 64; C = (st & 1) * 32 + (swz % 64) / 2; }
__device__ __forceinline__ int perm32(int rho) { const int n = rho >> 4, i = rho & 15; return 8 * (i >> 2) + 4 * n + (i & 3); }

struct Unit { int pm, pn; };
struct Gemm { const bf16_t* A; const bf16_t* Bt; int lda, K, a_pn_off; };

struct StaticOrder {
    int nM, nN, nwg, G, c;
    __device__ void init(int M, int N, int G_, int c_) { nM = M / BM; nN = N / BM; nwg = nM * nN; G = G_; c = c_; }
    __device__ bool next(int i, Unit& u) const {
        const int L = i * G + c; if (L >= nwg) return false;
        int wgid = L; { const int q = nwg / NXCD, r = nwg % NXCD, xcd = wgid % NXCD, off = wgid / NXCD; wgid = (xcd < r ? xcd * (q + 1) : r * (q + 1) + (xcd - r) * q) + off; }
        const int nig = WGM * nN, gid = wgid / nig, fm = gid * WGM, gsz = (nM - fm) < WGM ? (nM - fm) : WGM;
        u.pm = fm + ((wgid % nig) % gsz); u.pn = (wgid % nig) / gsz; return true;
    }
};

typedef f32x4 Acc[2][2][4][2];

template <class Epi>
__device__ __forceinline__ void gemm_phase(LAS unsigned char* lds, const Gemm g, const StaticOrder& S, const Epi& E, const int tid) {
    const int wid = __builtin_amdgcn_readfirstlane(tid >> 6), lane = tid & 63, wr = wid >> 2, wc = wid & 3, fr = lane & 15, fq = lane >> 4;
    const int K = g.K, nt = K / BK, lda = g.lda;
    unsigned voffA[2], voffB[2];
#pragma unroll
    for (int i = 0; i < 2; ++i) { int R, C; stage_rc(tid * 16 + i * 8192, R, C); const int Rb = (R & ~31) + perm32(R & 31);
        voffA[i] = (unsigned)(R * lda + C) * 2u; voffB[i] = (unsigned)(Rb * K + C) * 2u; }
    const size_t kstep = (size_t)(BK * 2);
    const size_t hstepA = (size_t)HALF * lda * 2, hstepB = (size_t)HALF * K * 2;
    const unsigned ldsw = (unsigned)wid * 1024u;
    const int aoff = lds_byte(wr * 64 + fr, fq * 8), boff = lds_byte(wc * 32 + fr, fq * 8);
#define PG8_SA(b, h) (((b) * 2 + (h)) * HTB)
#define PG8_SB(b, h) ((4 + (b) * 2 + (h)) * HTB)
#define PG8_STAGE(bufoff, gbase, voff) do { _Pragma("unroll") for (int _i = 0; _i < 2; ++_i) \
        __builtin_amdgcn_global_load_lds((const unsigned*)((const char*)(gbase) + (voff)[_i]), (LAS unsigned*)(lds + (bufoff) + ldsw + _i * 8192), 16, 0, 0); } while (0)
#define PG8_LDA(dst, b, h) do { _Pragma("unroll") for (int m = 0; m < 4; ++m) _Pragma("unroll") for (int k = 0; k < 2; ++k) dst[m][k] = *(const LAS bf16x8*)(lds + PG8_SA(b, h) + aoff + m * 2048 + k * 1024); } while (0)
#define PG8_LDB(dst, b, h) do { _Pragma("unroll") for (int n = 0; n < 2; ++n) _Pragma("unroll") for (int k = 0; k < 2; ++k) dst[n][k] = *(const LAS bf16x8*)(lds + PG8_SB(b, h) + boff + n * 2048 + k * 1024); } while (0)
#define PG8_MMA(ai, bj, At, Bt) do { __builtin_amdgcn_s_setprio(1); _Pragma("unroll") for (int m = 0; m < 4; ++m) _Pragma("unroll") for (int n = 0; n < 2; ++n) _Pragma("unroll") for (int k = 0; k < 2; ++k) \
        acc[ai][bj][m][n] = __builtin_amdgcn_mfma_f32_16x16x32_bf16(Bt[n][k], At[m][k], acc[ai][bj][m][n], 0, 0, 0); __builtin_amdgcn_s_setprio(0); } while (0)
#define PG8_WAIT_V(n) asm volatile("s_waitcnt vmcnt(" #n ")" ::: "memory")
#define PG8_WAIT_L(n) asm volatile("s_waitcnt lgkmcnt(" #n ")" ::: "memory")
#define PG8_BAR __builtin_amdgcn_s_barrier()
#define PG8_SCHED __builtin_amdgcn_sched_barrier(0)
    if (tid == 0) *(LAS int*)(lds + 131072 + 7168) = -1;
    Unit cur, nxt; int ui = 0;
    if (!S.next(0, cur)) return;
    f32x4 acc[2][2][4][2];
#pragma unroll
    for (int a = 0; a < 2; ++a)
#pragma unroll
        for (int b = 0; b < 2; ++b)
#pragma unroll
            for (int m = 0; m < 4; ++m)
#pragma unroll
                for (int n = 0; n < 2; ++n) acc[a][b][m][n] = (f32x4){0.f, 0.f, 0.f, 0.f};
    bf16x8 At[4][2], B0[2][2], B1[2][2];
    const char* cA = (const char*)g.A + ((size_t)cur.pm * BM * lda + (size_t)cur.pn * g.a_pn_off) * 2; const char* cB = (const char*)g.Bt + (size_t)cur.pn * 2 * hstepB;
    PG8_STAGE(PG8_SB(0, 0), cB, voffB); PG8_STAGE(PG8_SB(0, 1), cB + hstepB, voffB); PG8_STAGE(PG8_SA(0, 0), cA, voffA); PG8_STAGE(PG8_SA(0, 1), cA + hstepA, voffA);
    if (wr == 1) PG8_BAR;
    PG8_WAIT_V(2); PG8_BAR;
    PG8_STAGE(PG8_SB(1, 0), cB + kstep, voffB); PG8_STAGE(PG8_SA(1, 0), cA + kstep, voffA); PG8_STAGE(PG8_SB(1, 1), cB + hstepB + kstep, voffB);
    PG8_WAIT_V(6); PG8_BAR;
    for (;;) {
        const bool has_next = S.next(ui + 1, nxt);
        const char* nA = has_next ? (const char*)g.A + ((size_t)nxt.pm * BM * lda + (size_t)nxt.pn * g.a_pn_off) * 2 : cA; const char* nB = has_next ? (const char*)g.Bt + (size_t)nxt.pn * 2 * hstepB : cB;
        for (int t = 0; t < nt; t += 2) {
            const bool last = (t == nt - 2);
            const char* a1 = cA + (size_t)(t + 1) * kstep;
            const char* a2 = last ? nA : cA + (size_t)(t + 2) * kstep; const char* b2 = last ? nB : cB + (size_t)(t + 2) * kstep;
            const char* a3 = a2 + kstep; const char* b3 = b2 + kstep;
            PG8_LDB(B0, 0, 0); PG8_LDB(B1, 0, 1); PG8_SCHED; PG8_LDA(At, 0, 0); PG8_STAGE(PG8_SA(1, 1), a1 + hstepA, voffA);
            PG8_WAIT_V(8); PG8_WAIT_L(0); PG8_BAR; PG8_MMA(0, 0, At, B0); PG8_MMA(0, 1, At, B1); PG8_BAR; PG8_SCHED;
            PG8_LDA(At, 0, 1); PG8_STAGE(PG8_SB(0, 0), b2, voffB); PG8_STAGE(PG8_SB(0, 1), b2 + hstepB, voffB); PG8_STAGE(PG8_SA(0, 0), a2, voffA);
            PG8_WAIT_V(8); PG8_WAIT_L(0); PG8_BAR; PG8_MMA(1, 0, At, B0); PG8_MMA(1, 1, At, B1); PG8_BAR; PG8_SCHED;
            PG8_LDB(B0, 1, 0); PG8_LDB(B1, 1, 1); PG8_SCHED; PG8_LDA(At, 1, 0); PG8_STAGE(PG8_SA(0, 1), a2 + hstepA, voffA);
            PG8_WAIT_V(8); PG8_WAIT_L(0); PG8_BAR; PG8_MMA(0, 0, At, B0); PG8_MMA(0, 1, At, B1); PG8_BAR; PG8_SCHED;
            PG8_LDA(At, 1, 1); PG8_STAGE(PG8_SB(1, 0), b3, voffB); PG8_STAGE(PG8_SB(1, 1), b3 + hstepB, voffB); PG8_STAGE(PG8_SA(1, 0), a3, voffA);
            PG8_WAIT_V(8); PG8_WAIT_L(0); PG8_BAR; PG8_MMA(1, 0, At, B0); PG8_MMA(1, 1, At, B1); PG8_BAR; PG8_SCHED;
        }
        if (wr == 0) PG8_BAR;
        { int tl = tid; asm volatile("" : "+v"(tl)); E(acc, cur, wr, wc, fr, fq, lds + 131072, wid, tl & 63); }
        if (!has_next) break;
#pragma unroll
        for (int a = 0; a < 2; ++a)
#pragma unroll
            for (int b = 0; b < 2; ++b)
#pragma unroll
                for (int m = 0; m < 4; ++m)
#pragma unroll
                    for (int n = 0; n < 2; ++n) acc[a][b][m][n] = (f32x4){0.f, 0.f, 0.f, 0.f};
        cur = nxt; cA = nA; cB = nB; ++ui;
        if (wr == 1) PG8_BAR;
    }
    PG8_WAIT_V(0);
    PG8_BAR;
#undef PG8_SA
#undef PG8_SB
#undef PG8_STAGE
#undef PG8_LDA
#undef PG8_LDB
#undef PG8_MMA
#undef PG8_WAIT_V
#undef PG8_WAIT_L
#undef PG8_BAR
#undef PG8_SCHED
}

__device__ __forceinline__ u32x4 pack8(f32x4 v0, f32x4 v1) { u32x4 w; w.x = cvt_pk_bf16(v0[0], v0[1]); w.y = cvt_pk_bf16(v0[2], v0[3]); w.z = cvt_pk_bf16(v1[0], v1[1]); w.w = cvt_pk_bf16(v1[2], v1[3]); return w; }

__device__ __forceinline__ float rstd_from_pss(const float* pss, int row) {
    const GAS f32x4* p = (const GAS f32x4*)(pss + (size_t)row * 4); const f32x4 a = p[0], b = p[T], c = p[2 * T], d = p[3 * T];
    const float s = ((a[0] + a[1]) + (a[2] + a[3])) + ((b[0] + b[1]) + (b[2] + b[3])) + ((c[0] + c[1]) + (c[2] + c[3])) + ((d[0] + d[1]) + (d[2] + d[3]));
    return rsqrtf(s * (1.0f / D) + EPS);
}
__device__ __forceinline__ const LAS float* panel_rstd(const float* pss, int pm, LAS unsigned char* xl, int wid, int lane) {
    LAS float* S = (LAS float*)(xl + 6144); LAS int* tag = (LAS int*)(xl + 7168);
    const int t = __builtin_amdgcn_readfirstlane(*tag);
    if (t != pm) {
        asm volatile("s_waitcnt lgkmcnt(0)" ::: "memory"); __builtin_amdgcn_s_barrier(); asm volatile("" ::: "memory");
        const int tid = wid * 64 + lane;
        if (tid < 256) S[tid] = rstd_from_pss(pss, pm * BM + tid);
        if (tid == 0) *tag = pm;
        asm volatile("s_waitcnt lgkmcnt(0)" ::: "memory"); __builtin_amdgcn_s_barrier(); asm volatile("" ::: "memory");
    }
    return S;
}
struct EpiPlain {
    bf16_t* O; int ldc; const float* rs;
    __device__ __forceinline__ void operator()(const Acc& acc, const Unit& u, int wr, int wc, int fr, int fq, LAS unsigned char* xl, int wid, int lane) const {
        asm volatile("" : "+v"(lane)); fr = lane & 15; fq = lane >> 4;
        const int row0 = u.pm * BM + wr * 64 + fr, col0 = u.pn * BM + wc * 32 + 8 * fq;
#pragma unroll
        for (int ai = 0; ai < 2; ++ai)
#pragma unroll
            for (int m = 0; m < 4; ++m) { const int row = row0 + ai * HALF + m * 16; const float sc = rs ? rs[row] : 1.0f; bf16_t* rowp = O + (size_t)row * ldc + col0;
#pragma unroll
                for (int bj = 0; bj < 2; ++bj) *(GAS u32x4*)(rowp + bj * HALF) = pack8(acc[ai][bj][m][0] * sc, acc[ai][bj][m][1] * sc); }
    }
};
struct EpiSwiglu {
    bf16_t* O; const float* pss;
    __device__ __forceinline__ void operator()(const Acc& acc, const Unit& u, int wr, int wc, int fr, int fq, LAS unsigned char* xl, int wid, int lane) const {
        asm volatile("" : "+v"(lane)); fr = lane & 15; fq = lane >> 4;
        const int row0 = u.pm * BM + wr * 64 + fr, col0 = u.pn * HALF + wc * 32 + 8 * fq;
        const LAS float* RS_ = panel_rstd(pss, u.pm, xl, wid, lane);
#pragma unroll
        for (int ai = 0; ai < 2; ++ai)
#pragma unroll
            for (int m = 0; m < 4; ++m) { const int row = row0 + ai * HALF + m * 16; const float sc = RS_[ai * HALF + wr * 64 + m * 16 + fr];
                f32x4 o[2];
#pragma unroll
                for (int n = 0; n < 2; ++n)
#pragma unroll
                    for (int i = 0; i < 4; ++i) { const float gv = acc[ai][0][m][n][i] * sc, uv = acc[ai][1][m][n][i] * sc; o[n][i] = gv * sigmoid_f(gv) * uv; }
                *(GAS u32x4*)(O + (size_t)row * FF + col0) = pack8(o[0], o[1]); }
    }
};
struct EpiQKV {
    bf16_t *Q, *Kb, *Vb; const float *cosT, *sinT; const float* pss;
    __device__ __forceinline__ void operator()(const Acc& acc, const Unit& u, int wr, int wc, int fr, int fq, LAS unsigned char* xl, int wid, int lane) const {
        asm volatile("" : "+v"(lane)); fr = lane & 15; fq = lane >> 4;
        const int row0 = u.pm * BM + wr * 64 + fr;
        const LAS float* RS_ = panel_rstd(pss, u.pm, xl, wid, lane);
        if (u.pn < 5) {
            bf16_t* base; int ldc, colh;
            if (u.pn < 4) { base = Q; ldc = D; colh = (4 * u.pn + wc) * 64 + 8 * fq; } else { base = Kb; ldc = 256; colh = wc * 64 + 8 * fq; }
#pragma unroll
            for (int ai = 0; ai < 2; ++ai)
#pragma unroll
                for (int m = 0; m < 4; ++m) { const int row = row0 + ai * HALF + m * 16; const float sc = RS_[ai * HALF + wr * 64 + m * 16 + fr]; const int pos = row & (SEQ - 1);
                    const f32x4 c0 = *(const GAS f32x4*)(cosT + pos * 32 + 8 * fq), c1 = *(const GAS f32x4*)(cosT + pos * 32 + 8 * fq + 4);
                    const f32x4 s0 = *(const GAS f32x4*)(sinT + pos * 32 + 8 * fq), s1 = *(const GAS f32x4*)(sinT + pos * 32 + 8 * fq + 4);
                    const f32x4 a0 = acc[ai][0][m][0] * sc, a1 = acc[ai][0][m][1] * sc, b0 = acc[ai][1][m][0] * sc, b1 = acc[ai][1][m][1] * sc;
                    bf16_t* rowp = base + (size_t)row * ldc + colh;
                    *(GAS u32x4*)(rowp) = pack8(a0 * c0 - b0 * s0, a1 * c1 - b1 * s1);
                    *(GAS u32x4*)(rowp + 32) = pack8(b0 * c0 + a0 * s0, b1 * c1 + a1 * s1); }
        } else {
            const int col0 = wc * 32 + 8 * fq;
#pragma unroll
            for (int ai = 0; ai < 2; ++ai)
#pragma unroll
                for (int m = 0; m < 4; ++m) { const int row = row0 + ai * HALF + m * 16; const float sc = RS_[ai * HALF + wr * 64 + m * 16 + fr]; bf16_t* rowp = Vb + (size_t)row * 256 + col0;
#pragma unroll
                    for (int bj = 0; bj < 2; ++bj) *(GAS u32x4*)(rowp + bj * HALF) = pack8(acc[ai][bj][m][0] * sc, acc[ai][bj][m][1] * sc); }
        }
    }
};
template <bool SRC_F32> struct EpiNorm {
    const void* hsrc; bf16_t* HB; const float* g; float* pss; unsigned long long* xs; unsigned tag;
    __device__ __forceinline__ void operator()(const Acc& acc, const Unit& u, int wr, int wc, int fr, int fq, LAS unsigned char* xl, int wid, int lane) const {
        asm volatile("" : "+v"(lane)); fr = lane & 15; fq = lane >> 4;
        LAS float* P = (LAS float*)xl; LAS float* S = (LAS float*)(xl + 4096);
        const int col0 = u.pn * BM + wc * 32 + 8 * fq;
        u32x4 hpre[2][4][2];
        if (!SRC_F32) {
#pragma unroll
            for (int ai = 0; ai < 2; ++ai)
#pragma unroll
                for (int m = 0; m < 4; ++m)
#pragma unroll
                    for (int bj = 0; bj < 2; ++bj) hpre[ai][m][bj] = *(const GAS u32x4*)((const bf16_t*)hsrc + (size_t)(u.pm * BM + ai * HALF + wr * 64 + m * 16 + fr) * D + col0 + bj * HALF);
        }
#pragma unroll
        for (int ai = 0; ai < 2; ++ai)
#pragma unroll
            for (int m = 0; m < 4; ++m) { float ss = 0.f;
#pragma unroll
                for (int bj = 0; bj < 2; ++bj)
#pragma unroll
                    for (int n = 0; n < 2; ++n) { const f32x4 v = acc[ai][bj][m][n]; ss += (v[0] * v[0] + v[1] * v[1]) + (v[2] * v[2] + v[3] * v[3]); }
                ss += shx(ss, 16, lane); ss += shx(ss, 32, lane);
                if (fq == 0) P[(ai * HALF + wr * 64 + m * 16 + fr) * 4 + wc] = ss; }
        asm volatile("s_waitcnt lgkmcnt(0)" ::: "memory"); __builtin_amdgcn_s_barrier(); asm volatile("" ::: "memory");
        const int rl = wid * 32 + (lane & 31);
        if (lane < 32) {
            const f32x4 t4 = *(const LAS f32x4*)(P + rl * 4); const float s = (t4[0] + t4[1]) + (t4[2] + t4[3]);
            float v0 = s, v1 = s, v2 = s, v3 = s;
            unsigned long long* sl = xs + (size_t)(u.pm * BM + rl) * 4;
            __hip_atomic_store(sl + u.pn, ((unsigned long long)tag << 32) | (unsigned long long)__float_as_uint(s), __ATOMIC_RELAXED, __HIP_MEMORY_SCOPE_AGENT);
            unsigned done = 1u << u.pn, sp = 0;
            for (;;) {
#pragma unroll
                for (int t = 0; t < 4; ++t) if (!(done & (1u << t))) { const unsigned long long w = __hip_atomic_load(sl + t, __ATOMIC_RELAXED, __HIP_MEMORY_SCOPE_AGENT);
                    if ((unsigned)(w >> 32) == tag) { const float pv = __uint_as_float((unsigned)w); if (t == 0) v0 = pv; else if (t == 1) v1 = pv; else if (t == 2) v2 = pv; else v3 = pv; done |= 1u << t; } }
                if (__builtin_amdgcn_ballot_w64(done != 15u) == 0ull) break;
                if (++sp > (1u << 22)) break;
                __builtin_amdgcn_s_sleep(1);
            }
            S[rl] = rsqrtf(((v0 + v1) + (v2 + v3)) * (1.0f / D) + EPS);
        }
        asm volatile("s_waitcnt vmcnt(0) lgkmcnt(0)" ::: "memory"); __builtin_amdgcn_s_barrier(); asm volatile("" ::: "memory");
        f32x4 gv[2][2];
#pragma unroll
        for (int bj = 0; bj < 2; ++bj)
#pragma unroll
            for (int n = 0; n < 2; ++n) gv[bj][n] = *(const GAS f32x4*)(g + col0 + bj * HALF + 4 * n);
#pragma unroll
        for (int ai = 0; ai < 2; ++ai)
#pragma unroll
            for (int m = 0; m < 4; ++m) { const int rloc = ai * HALF + wr * 64 + m * 16 + fr; const float sr = S[rloc]; const int row = u.pm * BM + rloc; const size_t off = (size_t)row * D + col0; float ss = 0.f;
#pragma unroll
                for (int bj = 0; bj < 2; ++bj) {
                    f32x4 h0, h1;
                    if (SRC_F32) { h0 = *(const GAS f32x4*)((const float*)hsrc + off + bj * HALF); h1 = *(const GAS f32x4*)((const float*)hsrc + off + bj * HALF + 4); }
                    else { const u32x4 hw = hpre[ai][m][bj]; h0[0] = bf_lo(hw.x); h0[1] = bf_hi(hw.x); h0[2] = bf_lo(hw.y); h0[3] = bf_hi(hw.y); h1[0] = bf_lo(hw.z); h1[1] = bf_hi(hw.z); h1[2] = bf_lo(hw.w); h1[3] = bf_hi(hw.w); }
                    const f32x4 o0 = h0 + acc[ai][bj][m][0] * sr * gv[bj][0], o1 = h1 + acc[ai][bj][m][1] * sr * gv[bj][1];
                    ss += ((o0[0] * o0[0] + o0[1] * o0[1]) + (o0[2] * o0[2] + o0[3] * o0[3])) + ((o1[0] * o1[0] + o1[1] * o1[1]) + (o1[2] * o1[2] + o1[3] * o1[3]));
                    *(GAS u32x4*)(HB + off + bj * HALF) = pack8(o0, o1); }
                ss += shx(ss, 16, lane); ss += shx(ss, 32, lane);
                if (fq == 0) ((GAS float*)pss)[((size_t)u.pn * T + row) * 4 + wc] = ss;
                if (m & 1) asm volatile("" ::: "memory"); }
    }
};
template <bool LAST> struct EpiPle {
    const bf16_t* HX; bf16_t* HY; float* OUT; const bf16_t* PP; const float* pssa; float* pss;
    __device__ __forceinline__ void operator()(const Acc& acc, const Unit& u, int wr, int wc, int fr, int fq, LAS unsigned char* xl, int wid, int lane) const {
        asm volatile("" : "+v"(lane)); fr = lane & 15; fq = lane >> 4;
        const int row0 = u.pm * BM + wr * 64 + fr, col0 = u.pn * BM + wc * 32 + 8 * fq;
        const LAS float* RS_ = panel_rstd(pssa, u.pm, xl, wid, lane);
#pragma unroll
        for (int ai = 0; ai < 2; ++ai) {
            u32x4 hq[4][2], pq[4][2]; float scq[4];
#pragma unroll
            for (int m = 0; m < 4; ++m) { scq[m] = RS_[ai * HALF + wr * 64 + m * 16 + fr];
#pragma unroll
                for (int bj = 0; bj < 2; ++bj) { const size_t off = (size_t)(row0 + ai * HALF + m * 16) * D + col0 + bj * HALF; hq[m][bj] = *(const GAS u32x4*)(HX + off); pq[m][bj] = *(const GAS u32x4*)(PP + off); } }
            asm volatile("s_waitcnt vmcnt(0) lgkmcnt(0)" : "+v"(hq[0][0]), "+v"(hq[3][1]), "+v"(pq[0][0]), "+v"(pq[3][1]) :: "memory");
#pragma unroll
            for (int m = 0; m < 4; ++m) { const int row = row0 + ai * HALF + m * 16; const float sc = scq[m]; const size_t off = (size_t)row * D + col0; float ss = 0.f;
#pragma unroll
                for (int bj = 0; bj < 2; ++bj) {
                    const u32x4 hw = hq[m][bj]; const u32x4 pw = pq[m][bj];
                    f32x4 h0, h1, p0, p1;
                    h0[0] = bf_lo(hw.x); h0[1] = bf_hi(hw.x); h0[2] = bf_lo(hw.y); h0[3] = bf_hi(hw.y); h1[0] = bf_lo(hw.z); h1[1] = bf_hi(hw.z); h1[2] = bf_lo(hw.w); h1[3] = bf_hi(hw.w);
                    p0[0] = bf_lo(pw.x); p0[1] = bf_hi(pw.x); p0[2] = bf_lo(pw.y); p0[3] = bf_hi(pw.y); p1[0] = bf_lo(pw.z); p1[1] = bf_hi(pw.z); p1[2] = bf_lo(pw.w); p1[3] = bf_hi(pw.w);
                    f32x4 o0, o1;
#pragma unroll
                    for (int i = 0; i < 4; ++i) { o0[i] = h0[i] + p0[i] * sigmoid_f(acc[ai][bj][m][0][i] * sc); o1[i] = h1[i] + p1[i] * sigmoid_f(acc[ai][bj][m][1][i] * sc); ss += o0[i] * o0[i] + o1[i] * o1[i]; }
                    if (LAST) { *(GAS f32x4*)(OUT + off + bj * HALF) = o0; *(GAS f32x4*)(OUT + off + bj * HALF + 4) = o1; }
                    else *(GAS u32x4*)(HY + off + bj * HALF) = pack8(o0, o1); }
                if (!LAST) { ss += shx(ss, 16, lane); ss += shx(ss, 32, lane);
                    if (fq == 0) ((GAS float*)pss)[((size_t)u.pn * T + row) * 4 + wc] = ss; } }
            asm volatile("" ::: "memory"); }
    }
};
}

struct Job { const float* W; const float* gk; const float* gn; bf16_t* dst; int K, N, mode; float cs; };
constexpr int NJOBS = 34;
struct Args { const float* in[20]; float* out; unsigned char* ws; Job jobs[NJOBS]; };

__device__ __forceinline__ int dest_row(int mode, int n) {
    if (mode == 0) return n;
    if (mode == 1) return (n >> 7) * 256 + (n & 127);
    if (mode == 2) return (n >> 7) * 256 + 128 + (n & 127);
    const int head = n >> 6, d = n & 63; return (head >> 2) * 256 + (d >> 5) * 128 + (head & 3) * 32 + (d & 31);
}
__device__ __forceinline__ void wconv_item(const float* W, const float* gk, const float* gn, bf16_t* dst, int K, int N, int mode, float cs, LAS float* scr, int item, int lane) {
    const int nblk = N / 32, kb = item / nblk, nb = item % nblk, k0 = 64 * kb, n0 = 32 * nb;
    float wv[32];
#pragma unroll
    for (int i = 0; i < 32; ++i) wv[i] = ((const GAS float*)W)[(size_t)(k0 + 2 * i + (lane >> 5)) * N + n0 + (lane & 31)];
    if (gk) {
#pragma unroll
        for (int i = 0; i < 32; ++i) wv[i] *= ((const GAS float*)gk)[k0 + 2 * i + (lane >> 5)]; }
#pragma unroll
    for (int i = 0; i < 32; ++i) scr[(2 * i + (lane >> 5)) * 33 + (lane & 31)] = wv[i];
    asm volatile("s_waitcnt lgkmcnt(0)" ::: "memory");
    const int c = lane & 7;
#pragma unroll
    for (int j = 0; j < 4; ++j) { const int n = (lane >> 3) + 8 * j; const LAS float* s = scr + (8 * c) * 33 + n; const float sc = gn ? cs * ((const GAS float*)gn)[n0 + n] : cs;
        u32x4 o; o.x = cvt_pk_bf16(s[0 * 33] * sc, s[1 * 33] * sc); o.y = cvt_pk_bf16(s[2 * 33] * sc, s[3 * 33] * sc); o.z = cvt_pk_bf16(s[4 * 33] * sc, s[5 * 33] * sc); o.w = cvt_pk_bf16(s[6 * 33] * sc, s[7 * 33] * sc);
        *(GAS u32x4*)(dst + (size_t)dest_row(mode, n0 + n) * K + k0 + 8 * c) = o; }
    asm volatile("s_waitcnt lgkmcnt(0)" ::: "memory");
}
__device__ __forceinline__ void conv_p(const float* p, bf16_t* pb, int gtid, int nthr) {
    constexpr int NV = T * PLE / 8;
    for (int i = gtid; i < NV; i += 2 * nthr) { const int i2 = (i + nthr < NV) ? i + nthr : i;
        const f32x4 a = *(const GAS f32x4*)(p + (size_t)i * 8), b = *(const GAS f32x4*)(p + (size_t)i * 8 + 4), c = *(const GAS f32x4*)(p + (size_t)i2 * 8), d = *(const GAS f32x4*)(p + (size_t)i2 * 8 + 4);
        *(GAS u32x4*)(pb + (size_t)i * 8) = pg8::pack8(a, b); *(GAS u32x4*)(pb + (size_t)i2 * 8) = pg8::pack8(c, d); }
}

template <int W, bool SRC_F32>
__device__ __forceinline__ void pool_cols(const void* h, float gx, float gy, bf16_t* pooled, const LAS float* rsl, int first, int t0, int s0, int c) {
    f32x2 ring[16];
#pragma unroll
    for (int i = 0; i < 16; ++i) ring[i] = (f32x2){0.f, 0.f};
    float Sx = 0.f, Sy = 0.f;
    for (int tb = first; tb < t0 + 128; tb += 16) {
        f32x2 v[16];
#pragma unroll
        for (int i = 0; i < 16; ++i) { if (SRC_F32) v[i] = *(const GAS f32x2*)((const float*)h + (size_t)(tb + i) * D + c);
            else { const unsigned w = *(const GAS unsigned*)((const bf16_t*)h + (size_t)(tb + i) * D + c); v[i] = (f32x2){bf_lo(w), bf_hi(w)}; } }
        const bool emit = tb >= t0;
#pragma unroll
        for (int i = 0; i < 16; ++i) {
            const float r = rsl[tb + i - first]; const float hx = v[i].x * r * gx, hy = v[i].y * r * gy;
            Sx += hx - ring[(i - W) & 15].x; Sy += hy - ring[(i - W) & 15].y; ring[i] = (f32x2){hx, hy};
            if (emit) { const int s = s0 + (tb + i - t0); const int cnt = (s + 1 < W) ? s + 1 : W; const float inv = 1.0f / (float)cnt;
                *(GAS unsigned*)(pooled + (size_t)(tb + i) * D + c) = cvt_pk_bf16(Sx * inv - hx, Sy * inv - hy); }
        }
    }
}
template <bool SRC_F32>
__device__ __forceinline__ void pool_prep(const void* h, const float* gpre, bf16_t* pooled, LAS unsigned char* lds, int tid, int wave, int lane, const float* pss = nullptr) {
    LAS float* rsl = (LAS float*)lds;
    for (int run = blockIdx.x; run < T / 128; run += gridDim.x) {
        const int t0 = run * 128, s0 = t0 & (SEQ - 1), first = (s0 == 0) ? t0 : t0 - 16, nrows = t0 + 128 - first;
        if (!SRC_F32) { for (int r = tid; r < nrows; r += NTHREADS) rsl[r] = pg8::rstd_from_pss(pss, first + r); }
        else
        for (int rb = wave; rb < nrows; rb += 4 * NWAVES) {
            float ss[4];
            if (SRC_F32) { f32x4 v[4][4];
#pragma unroll
                for (int q = 0; q < 4; ++q) { const int r = (rb + NWAVES * q < nrows) ? rb + NWAVES * q : nrows - 1; const GAS f32x4* xr = (const GAS f32x4*)((const float*)h + (size_t)(first + r) * D) + lane;
#pragma unroll
                    for (int j = 0; j < 4; ++j) v[q][j] = xr[64 * j]; }
#pragma unroll
                for (int q = 0; q < 4; ++q) { float s = 0.f;
#pragma unroll
                    for (int j = 0; j < 4; ++j) s += (v[q][j][0] * v[q][j][0] + v[q][j][1] * v[q][j][1]) + (v[q][j][2] * v[q][j][2] + v[q][j][3] * v[q][j][3]);
                    ss[q] = s; } }
            else { ss[0] = ss[1] = ss[2] = ss[3] = 0.f; }
#pragma unroll
            for (int q = 0; q < 4; ++q) { const float s = wave_sum(ss[q], lane); const int r = rb + NWAVES * q; if (lane == 0 && r < nrows) rsl[r] = rsqrtf(s * (1.0f / D) + EPS); } }
        __syncthreads();
        const int c = 2 * tid, grp = tid >> 7; const float gx = ((const GAS float*)gpre)[c], gy = ((const GAS float*)gpre)[c + 1];
        if (grp == 0) pool_cols<2, SRC_F32>(h, gx, gy, pooled, rsl, first, t0, s0, c);
        else if (grp == 1) pool_cols<4, SRC_F32>(h, gx, gy, pooled, rsl, first, t0, s0, c);
        else if (grp == 2) pool_cols<8, SRC_F32>(h, gx, gy, pooled, rsl, first, t0, s0, c);
        else pool_cols<16, SRC_F32>(h, gx, gy, pooled, rsl, first, t0, s0, c);
        __syncthreads();
    }
}

__device__ __forceinline__ int crow(int r, int hi) { return (r & 3) + 8 * (r >> 2) + 4 * hi; }
constexpr int A_KOFF = 0, A_VOFF = 32768;
__device__ __forceinline__ void attn_load_kv(int u, const bf16_t* Kb, const bf16_t* Vb, u32x4 (&kw)[4], u32x4 (&vw)[4], int tid) {
    const int n = u & 127, bk = u >> 7, b = bk >> 2, kvh = bk & 3; const long kt0 = (long)b * SEQ + (long)n * 128 - 128;
#pragma unroll
    for (int i = 0; i < 4; ++i) { const int cidx = tid + 512 * i, kv = cidx >> 3, ch = cidx & 7;
        const bool ok = (n > 0 || kv >= 128); const unsigned msk = ok ? 0xffffffffu : 0u; const int kvs = ok ? kv : kv + 128;
        kw[i] = *(const GAS u32x4*)(Kb + (size_t)(kt0 + kvs) * 256 + kvh * 64 + ch * 8) & msk; vw[i] = *(const GAS u32x4*)(Vb + (size_t)(kt0 + kvs) * 256 + kvh * 64 + ch * 8) & msk; }
}
__device__ __forceinline__ void attn_phase(const bf16_t* Q, const bf16_t* Kb, const bf16_t* Vb, bf16_t* O, const float* sinks, LAS unsigned char* lds, int G, int tid, int wave, int lane) {
    const int r32 = lane & 31, hi = lane >> 5;
    int u = blockIdx.x; if (u >= 1024) return;
    u32x4 kw[4], vw[4]; attn_load_kv(u, Kb, Vb, kw, vw, tid);
    const float NEG = -__builtin_inff();
    for (; u < 1024; u += G) {
        const int n = u & 127, bk = u >> 7, b = bk >> 2, kvh = bk & 3; const long tok0 = (long)b * SEQ + (long)n * 128;
        const int head = kvh * 4 + (wave >> 1);
#pragma unroll
        for (int i = 0; i < 4; ++i) { const int cidx = tid + 512 * i, kv = cidx >> 3, ch = cidx & 7;
            *(LAS u32x4*)(lds + A_KOFF + kv * 128 + ((ch ^ ((kv >> 1) & 7)) << 4)) = kw[i];
            *(LAS u32x4*)(lds + A_VOFF + (ch >> 2) * 16384 + kv * 64 + (ch & 3) * 16) = vw[i]; }
        __syncthreads();
        if (u + G < 1024) attn_load_kv(u + G, Kb, Vb, kw, vw, tid);
        const float sink2 = ((const GAS float*)sinks)[head] * LOG2E;
#pragma unroll
        for (int it = 0; it < 2; ++it) {
            const int r0 = ((wave & 1) * 2 + it) * 32, jt0 = r0 >> 5;
            bf16x8 qf[4]; { const bf16_t* qp = Q + (size_t)(tok0 + r0 + r32) * D + head * 64 + hi * 8;
#pragma unroll
                for (int d0 = 0; d0 < 4; ++d0) qf[d0] = *(const GAS bf16x8*)(qp + d0 * 16); }
            f32x16 p[5];
            bf16x8 kf[2][4];
#define ATT_LDK(buf, j_) do { const int kvrow_ = (jt0 + (j_)) * 32 + r32; _Pragma("unroll") for (int d0 = 0; d0 < 4; ++d0) { const int ch_ = 2 * d0 + hi; \
                kf[buf][d0] = *(const LAS bf16x8*)(lds + A_KOFF + kvrow_ * 128 + ((ch_ ^ ((kvrow_ >> 1) & 7)) << 4)); } } while (0)
            ATT_LDK(0, 0);
#pragma unroll
            for (int j = 0; j < 5; ++j) {
                if (j < 4) ATT_LDK((j + 1) & 1, j + 1);
                const f32x16 zero16 = {0.f, 0.f, 0.f, 0.f, 0.f, 0.f, 0.f, 0.f, 0.f, 0.f, 0.f, 0.f, 0.f, 0.f, 0.f, 0.f};
                f32x16 c0 = zero16;
                if (j == 0 || j == 4) { int rl_ = r32; asm volatile("" : "+v"(rl_));
#pragma unroll
                    for (int r = 0; r < 16; ++r) c0[r] = ((j == 0) ? (crow(r, hi) <= rl_) : (crow(r, hi) > rl_)) ? NEG : 0.f; }
                p[j] = __builtin_amdgcn_mfma_f32_32x32x16_bf16(kf[j & 1][0], qf[0], c0, 0, 0, 0);
#pragma unroll
                for (int d0 = 1; d0 < 4; ++d0) p[j] = __builtin_amdgcn_mfma_f32_32x32x16_bf16(kf[j & 1][d0], qf[d0], p[j], 0, 0, 0); }
#undef ATT_LDK
            if (n == 0) {
#pragma unroll
                for (int j = 0; j < 5; ++j) if (jt0 + j < 4) {
#pragma unroll
                    for (int r = 0; r < 16; ++r) p[j][r] = NEG; }
            }
            float mx = sink2;
#pragma unroll
            for (int j = 0; j < 5; ++j)
#pragma unroll
                for (int r = 0; r < 16; ++r) mx = fmaxf(mx, p[j][r]);
            mx = fmaxf(mx, shx(mx, 32, lane));
            float sum = 0.f;
#pragma unroll
            for (int j = 0; j < 5; ++j)
#pragma unroll
                for (int r = 0; r < 16; ++r) { const float e = __builtin_amdgcn_exp2f(p[j][r] - mx); p[j][r] = e; sum += e; }
            sum += shx(sum, 32, lane);
            sum += __builtin_amdgcn_exp2f(sink2 - mx);
            const float inv = 1.0f / sum;
            f32x16 o[2];
            s16x4 vlo[2][2], vh8[2][2];
            LAS unsigned char* vbase = lds + A_VOFF + (jt0 * 32 + 4 * hi + ((lane >> 2) & 3)) * 64 + ((lane >> 4) & 1) * 32 + (lane & 3) * 8;
#define ATT_LDV(buf, t_) do { _Pragma("unroll") for (int dh = 0; dh < 2; ++dh) { LAS unsigned char* va_ = vbase + dh * 16384 + (t_) * 1024; \
                vlo[buf][dh] = __builtin_bit_cast(s16x4, __builtin_amdgcn_ds_read_tr16_b64_v4i16((LAS s16x4*)va_)); vh8[buf][dh] = __builtin_bit_cast(s16x4, __builtin_amdgcn_ds_read_tr16_b64_v4i16((LAS s16x4*)(va_ + 512))); } } while (0)
            ATT_LDV(0, 0);
#pragma unroll
            for (int t = 0; t < 10; ++t) { const int j = t >> 1, s = t & 1;
                if (t < 9) ATT_LDV((t + 1) & 1, t + 1);
                u32x4 pw; pw.x = cvt_pk_bf16(p[j][8 * s + 0], p[j][8 * s + 1]); pw.y = cvt_pk_bf16(p[j][8 * s + 2], p[j][8 * s + 3]);
                pw.z = cvt_pk_bf16(p[j][8 * s + 4], p[j][8 * s + 5]); pw.w = cvt_pk_bf16(p[j][8 * s + 6], p[j][8 * s + 7]);
                const bf16x8 pf = __builtin_bit_cast(bf16x8, pw);
#pragma unroll
                for (int dh = 0; dh < 2; ++dh) { const s16x4 lo = vlo[t & 1][dh], h8 = vh8[t & 1][dh];
                    const bf16x8 vf = (bf16x8){lo[0], lo[1], lo[2], lo[3], h8[0], h8[1], h8[2], h8[3]};
                    const f32x16 zero16 = {0.f, 0.f, 0.f, 0.f, 0.f, 0.f, 0.f, 0.f, 0.f, 0.f, 0.f, 0.f, 0.f, 0.f, 0.f, 0.f};
                    o[dh] = __builtin_amdgcn_mfma_f32_32x32x16_bf16(vf, pf, t == 0 ? zero16 : o[dh], 0, 0, 0); } }
#undef ATT_LDV
            bf16_t* op = O + (size_t)(tok0 + r0 + r32) * D + head * 64 + 4 * hi;
#pragma unroll
            for (int dh = 0; dh < 2; ++dh)
#pragma unroll
                for (int gq = 0; gq < 4; ++gq) { u32x2 w; w.x = cvt_pk_bf16(o[dh][4 * gq] * inv, o[dh][4 * gq + 1] * inv); w.y = cvt_pk_bf16(o[dh][4 * gq + 2] * inv, o[dh][4 * gq + 3] * inv); *(GAS u32x2*)(op + 32 * dh + 8 * gq) = w; }
        }
        __syncthreads();
    }
}

#define XB_TMO      128
#define XB_XCNT(j)  (256  + 64 * (j))
#define XB_XSUB(j)  (1280 + 64 * (j))
#define XB_XGEN(j)  (2304 + 64 * (j))
#define XB_TOP      3328
#define XB_TOPGEN   3392
#define XCD_BAR_WORDS 3456
#define XB_SPIN_CAP (1u << 22)
__device__ __forceinline__ unsigned xb_ld(unsigned* p)              { return __hip_atomic_load(p, __ATOMIC_RELAXED, __HIP_MEMORY_SCOPE_AGENT); }
__device__ __forceinline__ unsigned xb_add(unsigned* p, unsigned v) { return __hip_atomic_fetch_add(p, v, __ATOMIC_RELAXED, __HIP_MEMORY_SCOPE_AGENT); }
__device__ __forceinline__ unsigned xb_xcc_id() { return (unsigned)__builtin_amdgcn_s_getreg((3 << 11) | 20) & 0xFu; }
#define XB_SPIN(cond, bar) do { unsigned _sp = 0; while (cond) { __builtin_amdgcn_s_sleep(1); \
    if ((++_sp & 255u) == 0u) { if (xb_ld(&(bar)[XB_TMO])) break; if (_sp > XB_SPIN_CAP) { atomicAdd(&(bar)[XB_TMO], 1u); break; } } } } while (0)
struct XcdBarrier { unsigned* bar; unsigned x; volatile LAS unsigned* st; };
__device__ __forceinline__ XcdBarrier xcd_barrier_post(unsigned* bar, volatile LAS unsigned* st) {
    XcdBarrier b; b.bar = bar; b.x = 0; b.st = st;
    if (threadIdx.x == 0) (void)xb_add(&bar[XB_XCNT(xb_xcc_id())], 1u);
    return b;
}
__device__ __forceinline__ void xcd_barrier_complete(unsigned* bar, unsigned x, unsigned& nloc, unsigned& nx) {
    const unsigned G = gridDim.x * gridDim.y * gridDim.z;
    unsigned sum, cnt, mine, sp = 0u;
    for (;;) {
        sum = 0u; cnt = 0u; mine = 0u;
#pragma unroll
        for (unsigned j = 0; j < 16; ++j) { const unsigned c = xb_ld(&bar[XB_XCNT(j)]); sum += c; cnt += (c > 0u) ? 1u : 0u; mine = (j == x) ? c : mine; }
        if (sum == G) break;
        __builtin_amdgcn_s_sleep(1);
        if ((++sp & 255u) == 0u) { if (xb_ld(&bar[XB_TMO])) break; if (sp > XB_SPIN_CAP) { atomicAdd(&bar[XB_TMO], 1u); break; } }
    }
    nloc = mine > 0u ? mine : 1u; nx = cnt > 0u ? cnt : 1u;
}
__device__ __forceinline__ void xcd_barrier(const XcdBarrier& b, int wave_s) {
    asm volatile("s_waitcnt vmcnt(0) lgkmcnt(0)" ::: "memory");
    __syncthreads();
    unsigned m1_ = ~0u; asm volatile("" : "+s"(m1_));
    if (wave_s == 0 && __builtin_amdgcn_mbcnt_hi(m1_, __builtin_amdgcn_mbcnt_lo(m1_, 0u)) == 0u) {
        unsigned* bar = b.bar; asm volatile("" : "+s"(bar)); const unsigned bx = xb_xcc_id();
        __builtin_amdgcn_s_waitcnt(0);
        unsigned nloc = b.st[0], nx = b.st[1];
        if (nloc == 0u) { xcd_barrier_complete(bar, bx, nloc, nx); b.st[0] = nloc; b.st[1] = nx; }
        const unsigned old = xb_add(&bar[XB_XSUB(bx)], 1u);
        const unsigned gen = old / nloc;
        __builtin_amdgcn_fence(__ATOMIC_ACQUIRE, "agent");
        if (old == gen * nloc) {
            XB_SPIN(xb_ld(&bar[XB_XSUB(bx)]) < (gen + 1u) * nloc, bar);
            __builtin_amdgcn_fence(__ATOMIC_RELEASE, "agent");
            asm volatile("s_waitcnt vmcnt(0)" ::: "memory");
            const unsigned og = xb_add(&bar[XB_TOP], 1u);
            const unsigned tg = og / nx;
            if (og + 1u == (tg + 1u) * nx) xb_add(&bar[XB_TOPGEN], 1u);
            else XB_SPIN(xb_ld(&bar[XB_TOPGEN]) == tg, bar);
            xb_add(&bar[XB_XGEN(bx)], 1u);
        } else {
            XB_SPIN(xb_ld(&bar[XB_XGEN(bx)]) == gen, bar);
        }
        asm volatile("s_waitcnt vmcnt(0)" ::: "memory");
    }
    __syncthreads();
}
struct Ctx {
    int tid, lane, wave, G, gw, ngw, gtid, nthr;
    bf16_t *Wb, *HB, *MB, *ACT, *ATT, *KB, *VB, *PB, *PP; float *COS, *SIN, *PSSA, *PSSB; unsigned long long* XS;
};
__device__ __forceinline__ Ctx make_ctx(unsigned char* ws_in, int tid) {
    unsigned char* ws = (unsigned char*)(GAS unsigned char*)ws_in;
    Ctx c; c.tid = tid; c.lane = tid & 63; c.wave = __builtin_amdgcn_readfirstlane(tid >> 6); c.G = gridDim.x;
    c.gw = blockIdx.x * NWAVES + c.wave; c.ngw = c.G * NWAVES; c.gtid = blockIdx.x * NTHREADS + tid; c.nthr = c.G * NTHREADS;
    c.Wb = (bf16_t*)(ws + WS_W); c.HB = (bf16_t*)(ws + WS_HB); c.MB = (bf16_t*)(ws + WS_MB); c.ACT = (bf16_t*)(ws + WS_ACT); c.ATT = (bf16_t*)(ws + WS_ACT + 64 * MiB);
    c.KB = (bf16_t*)(ws + WS_K); c.VB = (bf16_t*)(ws + WS_V); c.PB = (bf16_t*)(ws + WS_PB);
    c.COS = (float*)(ws + WS_COS); c.SIN = (float*)(ws + WS_SIN); c.PSSA = (float*)(ws + WS_PSSA); c.PSSB = (float*)(ws + WS_PSSB); c.PP = (bf16_t*)(ws + WS_PP);
    c.XS = (unsigned long long*)(ws + WS_XS);
    return c;
}
#define GRID_SYNC() do { xcd_barrier(xbar, wave_s); } while (0)
#define PHASE_BEGIN() unsigned m1_ = ~0u; asm volatile("" : "+s"(m1_)); int tid_p = wave_s * 64 + (int)__builtin_amdgcn_mbcnt_hi(m1_, __builtin_amdgcn_mbcnt_lo(m1_, 0u)); asm volatile("" : "+s"(ws_s)); const Ctx C = make_ctx(ws_s, tid_p)
#define INP(k) ({ int kk_ = (k); asm volatile("" : "+s"(kk_)); (const float*)(GAS const float*)args.in[kk_]; })

__global__ void __launch_bounds__(NTHREADS, 2) mk_fwd(Args args) {
    extern __shared__ __attribute__((aligned(16))) unsigned char lds_raw[];
    LAS unsigned char* lds = (LAS unsigned char*)lds_raw;
    cg::grid_group grid = cg::this_grid();
    unsigned char* ws_s = args.ws;
    unsigned xuse = 0;
    int wave_s = __builtin_amdgcn_readfirstlane(threadIdx.x >> 6);
    volatile LAS unsigned* xst = (volatile LAS unsigned*)(lds + 131072 + 12288);
    if (threadIdx.x < 2) xst[threadIdx.x] = 0u;
    __syncthreads();
    const XcdBarrier xbar = xcd_barrier_post((unsigned*)(args.ws + WS_BAR), xst);
    if (__builtin_expect(args.ws == nullptr, 0)) grid.sync();
    float* H = (float*)(GAS float*)args.out;

    {
        PHASE_BEGIN();
        LAS float* scr = (LAS float*)(lds + C.wave * 16384);
        int base = 0;
#pragma nounroll
        for (int j = 0; j < NJOBS; ++j) {
            const float* W = args.jobs[j].W; const float* gk = args.jobs[j].gk; const float* gn = args.jobs[j].gn; bf16_t* dst = args.jobs[j].dst;
            const int K = args.jobs[j].K, N = args.jobs[j].N, mode = args.jobs[j].mode; const float cs = args.jobs[j].cs;
            const int nitems = (K / 64) * (N / 32);
            int it = (C.gw - base % C.ngw + C.ngw) % C.ngw;
            for (; it < nitems; it += C.ngw) wconv_item(W, gk, gn, dst, K, N, mode, cs, scr, it, C.lane);
            base += nitems;
        }
        for (int i = C.gtid; i < SEQ * 32; i += C.nthr) { const int pos = i >> 5, dd = i & 31;
            const float inv = __builtin_amdgcn_exp2f(-(float)dd * 0.41524101186092029f);
            const double rev = (double)pos * (double)inv * 0.15915494309189535; const float f = (float)(rev - __builtin_floor(rev));
            ((GAS float*)C.COS)[i] = __builtin_amdgcn_cosf(f); ((GAS float*)C.SIN)[i] = __builtin_amdgcn_sinf(f); }
        conv_p(INP(1), C.PB, C.gtid, C.nthr);
        __syncthreads();
        pool_prep<true>(INP(0), INP(2), C.ACT, lds, C.tid, C.wave, C.lane);
    }
    GRID_SYNC();

#pragma nounroll
    for (int L = 0; L < 4; ++L) {
        if (L < 2) {
            if (L == 1) { PHASE_BEGIN(); conv_p(INP(1) + (size_t)L * T * PLE, C.PB, C.gtid, C.nthr); pool_prep<false>(C.MB, INP(2) + L * D, C.ACT, lds, C.tid, C.wave, C.lane, C.PSSB); GRID_SYNC(); }
            { PHASE_BEGIN(); ++xuse; pg8::Gemm g{C.ACT, C.Wb + W_POOL + L * W_POOL_SZ, D, 256, 256}; pg8::StaticOrder S; S.init(T, D, C.G, blockIdx.x);
              if (L == 0) { pg8::EpiNorm<true> E{INP(0), C.HB, INP(3) + L * D, C.PSSA, C.XS, xuse}; pg8::gemm_phase(lds, g, S, E, C.tid); }
              else { pg8::EpiNorm<false> E{C.MB, C.HB, INP(3) + L * D, C.PSSA, C.XS, xuse}; pg8::gemm_phase(lds, g, S, E, C.tid); } }
            GRID_SYNC();
        } else {
            const int j = L - 2;
            { PHASE_BEGIN(); conv_p(INP(1) + (size_t)L * T * PLE, C.PB, C.gtid, C.nthr);
              pg8::Gemm g{C.MB, j == 0 ? C.Wb + W_QKV : C.Wb + W_Q3, D, D, 0}; pg8::StaticOrder S; S.init(T, j == 0 ? 1536 : D, C.G, blockIdx.x);
              pg8::EpiQKV E{C.ACT, C.KB, C.VB, C.COS, C.SIN, C.PSSB}; pg8::gemm_phase(lds, g, S, E, C.tid); }
            GRID_SYNC();
            { PHASE_BEGIN(); const float* sinks = INP(13) + j * 16;
              attn_phase(C.ACT, C.KB, C.VB, C.ATT, sinks, lds, C.G, C.tid, C.wave, C.lane); }
            GRID_SYNC();
            { PHASE_BEGIN(); ++xuse; pg8::Gemm g{C.ATT, C.Wb + W_O + (size_t)j * D * D, D, D, 0}; pg8::StaticOrder S; S.init(T, D, C.G, blockIdx.x);
              pg8::EpiNorm<false> E{C.MB, C.HB, INP(3) + L * D, C.PSSA, C.XS, xuse}; pg8::gemm_phase(lds, g, S, E, C.tid); }
            GRID_SYNC();
        }
        { PHASE_BEGIN(); pg8::Gemm g{C.HB, C.Wb + W_GU + L * W_GU_SZ, D, D, 0}; pg8::StaticOrder S; S.init(T, 2 * FF, C.G, blockIdx.x);
          pg8::EpiSwiglu E{C.ACT, C.PSSA}; pg8::gemm_phase(lds, g, S, E, C.tid); }
        { PHASE_BEGIN(); pg8::Gemm g{C.PB, C.Wb + W_PP + L * W_PP_SZ, PLE, PLE, 0}; pg8::StaticOrder S; S.init(T, D, C.G, blockIdx.x);
          pg8::EpiPlain E{C.PP, D, nullptr}; pg8::gemm_phase(lds, g, S, E, C.tid); }
        GRID_SYNC();
        { PHASE_BEGIN(); ++xuse; pg8::Gemm g{C.ACT, C.Wb + W_D + L * W_D_SZ, FF, FF, 0}; pg8::StaticOrder S; S.init(T, D, C.G, blockIdx.x);
          pg8::EpiNorm<false> E{C.HB, C.HB, INP(5) + L * D, C.PSSA, C.XS, xuse}; pg8::gemm_phase(lds, g, S, E, C.tid); }
        GRID_SYNC();
        { PHASE_BEGIN(); pg8::Gemm g{C.HB, C.Wb + W_PG + L * W_PG_SZ, D, D, 0}; pg8::StaticOrder S; S.init(T, D, C.G, blockIdx.x);
          if (L < 3) { pg8::EpiPle<false> E{C.HB, C.MB, H, C.PP, C.PSSA, C.PSSB}; pg8::gemm_phase(lds, g, S, E, C.tid); }
          else { pg8::EpiPle<true> E{C.HB, C.MB, H, C.PP, C.PSSA, C.PSSB}; pg8::gemm_phase(lds, g, S, E, C.tid); } }
        if (L < 3) GRID_SYNC();
    }
}

extern "C" void kernel_launch(void* const* d_in, const int* in_sizes, int n_in, void* d_out, int out_size, void* d_ws, size_t ws_size, hipStream_t stream) {
    static int grid = 0;
    if (grid == 0) {
        if (n_in != 20 || out_size != T * D || ws_size < WS_END) { fprintf(stderr, "kernel_launch: unexpected shapes (n_in %d out %d ws %zu)\n", n_in, out_size, ws_size); grid = -1; return; }
        int dev = 0, cus = 0, per_cu = 0;
        hipGetDevice(&dev); hipDeviceGetAttribute(&cus, hipDeviceAttributeMultiprocessorCount, dev);
        hipFuncSetAttribute((const void*)mk_fwd, hipFuncAttributeMaxDynamicSharedMemorySize, LDS_BYTES);
        if (hipOccupancyMaxActiveBlocksPerMultiprocessor(&per_cu, (const void*)mk_fwd, NTHREADS, LDS_BYTES) != hipSuccess || per_cu < 1) per_cu = 1;
        (void)hipGetLastError();
        grid = cus * per_cu;
    }
    if (grid < 0) return;
    Args a{};
    for (int i = 0; i < 20; ++i) a.in[i] = (const float*)d_in[i];
    a.out = (float*)d_out; a.ws = (unsigned char*)d_ws;
    bf16_t* Wb = (bf16_t*)((unsigned char*)d_ws + WS_W);
    const float *mix_pre_g = a.in[2], *ffn_pre_g = a.in[4], *pool_w = a.in[6], *pool_scale = a.in[7], *kv_norm_g = a.in[8], *w_k = a.in[9], *w_v = a.in[10], *w_q = a.in[11], *w_o = a.in[12];
    const float *w_gate = a.in[14], *w_up = a.in[15], *w_down = a.in[16], *ple_norm_g = a.in[17], *w_pleg = a.in[18], *w_plep = a.in[19];
    int nj = 0;
    auto add = [&](const float* W, const float* gk, const float* gn, bf16_t* dst, int K, int N, int mode, float cs) { Job& J = a.jobs[nj++]; J.W = W; J.gk = gk; J.gn = gn; J.dst = dst; J.K = K; J.N = N; J.mode = mode; J.cs = cs; };
    for (int i = 0; i < 4; ++i) {
        add(w_gate + (size_t)i * D * FF, ffn_pre_g + i * D, nullptr, Wb + W_GU + i * W_GU_SZ, D, FF, 1, 1.f);
        add(w_up + (size_t)i * D * FF, ffn_pre_g + i * D, nullptr, Wb + W_GU + i * W_GU_SZ, D, FF, 2, 1.f);
        add(w_down + (size_t)i * FF * D, nullptr, nullptr, Wb + W_D + i * W_D_SZ, FF, D, 0, 1.f);
        add(w_pleg + (size_t)i * D * D, ple_norm_g + i * D, nullptr, Wb + W_PG + i * W_PG_SZ, D, D, 0, 1.f);
        add(w_plep + (size_t)i * PLE * D, nullptr, nullptr, Wb + W_PP + i * W_PP_SZ, PLE, D, 0, 1.f);
    }
    for (int i = 0; i < 2; ++i) for (int g = 0; g < 4; ++g)
        add(pool_w + ((size_t)i * 4 + g) * 256 * 256, nullptr, pool_scale + i * D + g * 256, Wb + W_POOL + i * W_POOL_SZ + (size_t)g * 256 * 256, 256, 256, 0, 1.f);
    add(w_q, mix_pre_g + 2 * D, nullptr, Wb + W_QKV, D, D, 3, C2);
    add(w_k, kv_norm_g, nullptr, Wb + W_QKV + (size_t)1024 * D, D, 256, 3, 1.f);
    add(w_v, kv_norm_g, nullptr, Wb + W_QKV + (size_t)1280 * D, D, 256, 0, 1.f);
    add(w_q + (size_t)D * D, mix_pre_g + 3 * D, nullptr, Wb + W_Q3, D, D, 3, C2);
    add(w_o, nullptr, nullptr, Wb + W_O, D, D, 0, 1.f);
    add(w_o + (size_t)D * D, nullptr, nullptr, Wb + W_O + (size_t)D * D, D, D, 0, 1.f);
    (void)hipMemsetAsync((unsigned char*)d_ws + WS_BAR, 0, BAR_ZERO_BYTES, stream);
    void* kargs[] = {&a};
    hipError_t e = hipLaunchCooperativeKernel((const void*)mk_fwd, dim3(grid), dim3(NTHREADS), kargs, LDS_BYTES, stream);
    if (e != hipSuccess) fprintf(stderr, "cooperative launch failed: %s (grid %d)\n", hipGetErrorString(e), grid);
}
```

```cpp
#include <hip/hip_runtime.h>
#include <hip/hip_cooperative_groups.h>
#include <cstdint>
#include <cstdio>
namespace cg = cooperative_groups;

#define LAS __attribute__((address_space(3)))
#define GAS __attribute__((address_space(1)))
typedef unsigned short bf16_t;
typedef short bf16x8 __attribute__((ext_vector_type(8)));
typedef short s16x4 __attribute__((ext_vector_type(4)));
typedef float f32x4 __attribute__((ext_vector_type(4)));
typedef float f32x2 __attribute__((ext_vector_type(2)));
typedef float f32x16 __attribute__((ext_vector_type(16)));
typedef unsigned u32x4 __attribute__((ext_vector_type(4)));
typedef unsigned u32x2 __attribute__((ext_vector_type(2)));

constexpr int T = 32768, SEQ = 16384, D = 1024, FF = 2816, PLE = 256;
constexpr float EPS = 1e-6f;
constexpr float LOG2E = 1.4426950408889634f;
constexpr float C2 = 0.125f * LOG2E;
constexpr int NWAVES = 8, NTHREADS = 512;

constexpr size_t MiB = 1u << 20;
constexpr size_t WS_W = 0;
constexpr size_t WS_HB = 88 * MiB;
constexpr size_t WS_MB = 152 * MiB;
constexpr size_t WS_ACT = 216 * MiB;
constexpr size_t WS_K = 392 * MiB, WS_V = 408 * MiB, WS_PB = 424 * MiB;
constexpr size_t WS_COS = 440 * MiB, WS_SIN = 442 * MiB, WS_PSSA = 444 * MiB, WS_PSSB = 446 * MiB, WS_PP = 448 * MiB, WS_END = 512 * MiB;
constexpr size_t WS_BAR = 86 * MiB;
constexpr size_t WS_XS = 87 * MiB;
constexpr size_t BAR_ZERO_BYTES = 65536;
constexpr size_t W_GU = 0, W_GU_SZ = (size_t)2 * FF * D;
constexpr size_t W_D = W_GU + 4 * W_GU_SZ, W_D_SZ = (size_t)D * FF;
constexpr size_t W_PG = W_D + 4 * W_D_SZ, W_PG_SZ = (size_t)D * D;
constexpr size_t W_PP = W_PG + 4 * W_PG_SZ, W_PP_SZ = (size_t)D * PLE;
constexpr size_t W_POOL = W_PP + 4 * W_PP_SZ, W_POOL_SZ = (size_t)D * 256;
constexpr size_t W_QKV = W_POOL + 2 * W_POOL_SZ, W_QKV_SZ = (size_t)1536 * D;
constexpr size_t W_Q3 = W_QKV + W_QKV_SZ;
constexpr size_t W_O = W_Q3 + (size_t)D * D;
constexpr size_t W_END = W_O + 2 * (size_t)D * D;
static_assert(W_END * 2 <= WS_BAR, "weights fit");

constexpr int LDS_BYTES = 147456;

typedef __bf16 bf16x2_t __attribute__((ext_vector_type(2)));
__device__ __forceinline__ unsigned cvt_pk_bf16(float lo, float hi) { const f32x2 v = {lo, hi}; const bf16x2_t b = __builtin_convertvector(v, bf16x2_t); return __builtin_bit_cast(unsigned, b); }
__device__ __forceinline__ float bf_lo(unsigned w) { return __uint_as_float(w << 16); }
__device__ __forceinline__ float bf_hi(unsigned w) { return __uint_as_float(w & 0xffff0000u); }
__device__ __forceinline__ float shx(float v, int mask, int lane) { return __int_as_float(__builtin_amdgcn_ds_bpermute((lane ^ mask) << 2, __float_as_int(v))); }
__device__ __forceinline__ float wave_sum(float v, int lane) {
#pragma unroll
    for (int o = 1; o < 64; o <<= 1) v += shx(v, o, lane);
    return v;
}
__device__ __forceinline__ float sigmoid_f(float v) { return __builtin_amdgcn_rcpf(1.0f + __expf(-v)); }

namespace pg8 {
constexpr int BM = 256, BK = 64, HALF = 128, HTB = HALF * BK * 2, STAGE_BYTES = 8 * HTB, NXCD = 8, WGM = 8;
__device__ __forceinline__ int lds_byte(int r, int c) { const int st = (r >> 4) * 2 + (c >> 5), rr = r & 15, cc = c & 31, ob = rr * 64 + cc * 2; return st * 1024 + (ob ^ (((ob >> 9) & 1) << 5)); }
__device__ __forceinline__ void stage_rc(int b, int& R, int& C) { const int st = b / 1024, sb = b % 1024, swz = sb ^ (((sb >> 9) & 1) << 5); R = (st >> 1) * 16 + swz / 64; C = (st & 1) * 32 + (swz % 64) / 2; }
__device__ __forceinline__ int perm32(int rho) { const int n = rho >> 4, i = rho & 15; return 8 * (i >> 2) + 4 * n + (i & 3); }

struct Unit { int pm, pn; };
struct Gemm { const bf16_t* A; const bf16_t* Bt; int lda, K, a_pn_off; };

struct StaticOrder {
    int nM, nN, nwg, G, c;
    __device__ void init(int M, int N, int G_, int c_) { nM = M / BM; nN = N / BM; nwg = nM * nN; G = G_; c = c_; }
    __device__ bool next(int i, Unit& u) const {
        const int L = i * G + c; if (L >= nwg) return false;
        int wgid = L; { const int q = nwg / NXCD, r = nwg % NXCD, xcd = wgid % NXCD, off = wgid / NXCD; wgid = (xcd < r ? xcd * (q + 1) : r * (q + 1) + (xcd - r) * q) + off; }
        const int nig = WGM * nN, gid = wgid / nig, fm = gid * WGM, gsz = (nM - fm) < WGM ? (nM - fm) : WGM;
        u.pm = fm + ((wgid % nig) % gsz); u.pn = (wgid % nig) / gsz; return true;
    }
};

typedef f32x4 Acc[2][2][4][2];

template <class Epi>
__device__ __forceinline__ void gemm_phase(LAS unsigned char* lds, const Gemm g, const StaticOrder& S, const Epi& E, const int tid) {
    const int wid = __builtin_amdgcn_readfirstlane(tid >> 6), lane = tid & 63, wr = wid >> 2, wc = wid & 3, fr = lane & 15, fq = lane >> 4;
    const int K = g.K, nt = K / BK, lda = g.lda;
    unsigned voffA[2], voffB[2];
#pragma unroll
    for (int i = 0; i < 2; ++i) { int R, C; stage_rc(tid * 16 + i * 8192, R, C); const int Rb = (R & ~31) + perm32(R & 31);
        voffA[i] = (unsigned)(R * lda + C) * 2u; voffB[i] = (unsigned)(Rb * K + C) * 2u; }
    const size_t kstep = (size_t)(BK * 2);
    const size_t hstepA = (size_t)HALF * lda * 2, hstepB = (size_t)HALF * K * 2;
    const unsigned ldsw = (unsigned)wid * 1024u;
    const int aoff = lds_byte(wr * 64 + fr, fq * 8), boff = lds_byte(wc * 32 + fr, fq * 8);
#define PG8_SA(b, h) (((b) * 2 + (h)) * HTB)
#define PG8_SB(b, h) ((4 + (b) * 2 + (h)) * HTB)
#define PG8_STAGE(bufoff, gbase, voff) do { _Pragma("unroll") for (int _i = 0; _i < 2; ++_i) \
        __builtin_amdgcn_global_load_lds((const unsigned*)((const char*)(gbase) + (voff)[_i]), (LAS unsigned*)(lds + (bufoff) + ldsw + _i * 8192), 16, 0, 0); } while (0)
#define PG8_LDA(dst, b, h) do { _Pragma("unroll") for (int m = 0; m < 4; ++m) _Pragma("unroll") for (int k = 0; k < 2; ++k) dst[m][k] = *(const LAS bf16x8*)(lds + PG8_SA(b, h) + aoff + m * 2048 + k * 1024); } while (0)
#define PG8_LDB(dst, b, h) do { _Pragma("unroll") for (int n = 0; n < 2; ++n) _Pragma("unroll") for (int k = 0; k < 2; ++k) dst[n][k] = *(const LAS bf16x8*)(lds + PG8_SB(b, h) + boff + n * 2048 + k * 1024); } while (0)
#define PG8_MMA(ai, bj, At, Bt) do { __builtin_amdgcn_s_setprio(1); _Pragma("unroll") for (int m = 0; m < 4; ++m) _Pragma("unroll") for (int n = 0; n < 2; ++n) _Pragma("unroll") for (int k = 0; k < 2; ++k) \
        acc[ai][bj][m][n] = __builtin_amdgcn_mfma_f32_16x16x32_bf16(Bt[n][k], At[m][k], acc[ai][bj][m][n], 0, 0, 0); __builtin_amdgcn_s_setprio(0); } while (0)
#define PG8_WAIT_V(n) asm volatile("s_waitcnt vmcnt(" #n ")" ::: "memory")
#define PG8_WAIT_L(n) asm volatile("s_waitcnt lgkmcnt(" #n ")" ::: "memory")
#define PG8_BAR __builtin_amdgcn_s_barrier()
#define PG8_SCHED __builtin_amdgcn_sched_barrier(0)
    if (tid == 0) *(LAS int*)(lds + 131072 + 7168) = -1;
    Unit cur, nxt; int ui = 0;
    if (!S.next(0, cur)) return;
    f32x4 acc[2][2][4][2];
#pragma unroll
    for (int a = 0; a < 2; ++a)
#pragma unroll
        for (int b = 0; b < 2; ++b)
#pragma unroll
            for (int m = 0; m < 4; ++m)
#pragma unroll
                for (int n = 0; n < 2; ++n) acc[a][b][m][n] = (f32x4){0.f, 0.f, 0.f, 0.f};
    bf16x8 At[4][2], B0[2][2], B1[2][2];
    const char* cA = (const char*)g.A + ((size_t)cur.pm * BM * lda + (size_t)cur.pn * g.a_pn_off) * 2; const char* cB = (const char*)g.Bt + (size_t)cur.pn * 2 * hstepB;
    PG8_STAGE(PG8_SB(0, 0), cB, voffB); PG8_STAGE(PG8_SB(0, 1), cB + hstepB, voffB); PG8_STAGE(PG8_SA(0, 0), cA, voffA); PG8_STAGE(PG8_SA(0, 1), cA + hstepA, voffA);
    if (wr == 1) PG8_BAR;
    PG8_WAIT_V(2); PG8_BAR;
    PG8_STAGE(PG8_SB(1, 0), cB + kstep, voffB); PG8_STAGE(PG8_SA(1, 0), cA + kstep, voffA); PG8_STAGE(PG8_SB(1, 1), cB + hstepB + kstep, voffB);
    PG8_WAIT_V(6); PG8_BAR;
    for (;;) {
        const bool has_next = S.next(ui + 1, nxt);
        const char* nA = has_next ? (const char*)g.A + ((size_t)nxt.pm * BM * lda + (size_t)nxt.pn * g.a_pn_off) * 2 : cA; const char* nB = has_next ? (const char*)g.Bt + (size_t)nxt.pn * 2 * hstepB : cB;
        for (int t = 0; t < nt; t += 2) {
            const bool last = (t == nt - 2);
            const char* a1 = cA + (size_t)(t + 1) * kstep;
            const char* a2 = last ? nA : cA + (size_t)(t + 2) * kstep; const char* b2 = last ? nB : cB + (size_t)(t + 2) * kstep;
            const char* a3 = a2 + kstep; const char* b3 = b2 + kstep;
            PG8_LDB(B0, 0, 0); PG8_LDB(B1, 0, 1); PG8_SCHED; PG8_LDA(At, 0, 0); PG8_STAGE(PG8_SA(1, 1), a1 + hstepA, voffA);
            PG8_WAIT_V(8); PG8_WAIT_L(0); PG8_BAR; PG8_MMA(0, 0, At, B0); PG8_MMA(0, 1, At, B1); PG8_BAR; PG8_SCHED;
            PG8_LDA(At, 0, 1); PG8_STAGE(PG8_SB(0, 0), b2, voffB); PG8_STAGE(PG8_SB(0, 1), b2 + hstepB, voffB); PG8_STAGE(PG8_SA(0, 0), a2, voffA);
            PG8_WAIT_V(8); PG8_WAIT_L(0); PG8_BAR; PG8_MMA(1, 0, At, B0); PG8_MMA(1, 1, At, B1); PG8_BAR; PG8_SCHED;
            PG8_LDB(B0, 1, 0); PG8_LDB(B1, 1, 1); PG8_SCHED; PG8_LDA(At, 1, 0); PG8_STAGE(PG8_SA(0, 1), a2 + hstepA, voffA);
            PG8_WAIT_V(8); PG8_WAIT_L(0); PG8_BAR; PG8_MMA(0, 0, At, B0); PG8_MMA(0, 1, At, B1); PG8_BAR; PG8_SCHED;
            PG8_LDA(At, 1, 1); PG8_STAGE(PG8_SB(1, 0), b3, voffB); PG8_STAGE(PG8_SB(1, 1), b3 + hstepB, voffB); PG8_STAGE(PG8_SA(1, 0), a3, voffA);
            PG8_WAIT_V(8); PG8_WAIT_L(0); PG8_BAR; PG8_MMA(1, 0, At, B0); PG8_MMA(1, 1, At, B1); PG8_BAR; PG8_SCHED;
        }
        if (wr == 0) PG8_BAR;
        { int tl = tid; asm volatile("" : "+v"(tl)); E(acc, cur, wr, wc, fr, fq, lds + 131072, wid, tl & 63); }
        if (!has_next) break;
#pragma unroll
        for (int a = 0; a < 2; ++a)
#pragma unroll
            for (int b = 0; b < 2; ++b)
#pragma unroll
                for (int m = 0; m < 4; ++m)
#pragma unroll
                    for (int n = 0; n < 2; ++n) acc[a][b][m][n] = (f32x4){0.f, 0.f, 0.f, 0.f};
        cur = nxt; cA = nA; cB = nB; ++ui;
        if (wr == 1) PG8_BAR;
    }
    PG8_WAIT_V(0);
    PG8_BAR;
#undef PG8_SA
#undef PG8_SB
#undef PG8_STAGE
#undef PG8_LDA
#undef PG8_LDB
#undef PG8_MMA
#undef PG8_WAIT_V
#undef PG8_WAIT_L
#undef PG8_BAR
#undef PG8_SCHED
}

__device__ __forceinline__ u32x4 pack8(f32x4 v0, f32x4 v1) { u32x4 w; w.x = cvt_pk_bf16(v0[0], v0[1]); w.y = cvt_pk_bf16(v0[2], v0[3]); w.z = cvt_pk_bf16(v1[0], v1[1]); w.w = cvt_pk_bf16(v1[2], v1[3]); return w; }

__device__ __forceinline__ float rstd_from_pss(const float* pss, int row) {
    const GAS f32x4* p = (const GAS f32x4*)(pss + (size_t)row * 4); const f32x4 a = p[0], b = p[T], c = p[2 * T], d = p[3 * T];
    const float s = ((a[0] + a[1]) + (a[2] + a[3])) + ((b[0] + b[1]) + (b[2] + b[3])) + ((c[0] + c[1]) + (c[2] + c[3])) + ((d[0] + d[1]) + (d[2] + d[3]));
    return rsqrtf(s * (1.0f / D) + EPS);
}
__device__ __forceinline__ const LAS float* panel_rstd(const float* pss, int pm, LAS unsigned char* xl, int wid, int lane) {
    LAS float* S = (LAS float*)(xl + 6144); LAS int* tag = (LAS int*)(xl + 7168);
    const int t = __builtin_amdgcn_readfirstlane(*tag);
    if (t != pm) {
        asm volatile("s_waitcnt lgkmcnt(0)" ::: "memory"); __builtin_amdgcn_s_barrier(); asm volatile("" ::: "memory");
        const int tid = wid * 64 + lane;
        if (tid < 256) S[tid] = rstd_from_pss(pss, pm * BM + tid);
        if (tid == 0) *tag = pm;
        asm volatile("s_waitcnt lgkmcnt(0)" ::: "memory"); __builtin_amdgcn_s_barrier(); asm volatile("" ::: "memory");
    }
    return S;
}
struct EpiPlain {
    bf16_t* O; int ldc; const float* rs;
    __device__ __forceinline__ void operator()(const Acc& acc, const Unit& u, int wr, int wc, int fr, int fq, LAS unsigned char* xl, int wid, int lane) const {
        asm volatile("" : "+v"(lane)); fr = lane & 15; fq = lane >> 4;
        const int row0 = u.pm * BM + wr * 64 + fr, col0 = u.pn * BM + wc * 32 + 8 * fq;
#pragma unroll
        for (int ai = 0; ai < 2; ++ai)
#pragma unroll
            for (int m = 0; m < 4; ++m) { const int row = row0 + ai * HALF + m * 16; const float sc = rs ? rs[row] : 1.0f; bf16_t* rowp = O + (size_t)row * ldc + col0;
#pragma unroll
                for (int bj = 0; bj < 2; ++bj) *(GAS u32x4*)(rowp + bj * HALF) = pack8(acc[ai][bj][m][0] * sc, acc[ai][bj][m][1] * sc); }
    }
};
struct EpiSwiglu {
    bf16_t* O; const float* pss;
    __device__ __forceinline__ void operator()(const Acc& acc, const Unit& u, int wr, int wc, int fr, int fq, LAS unsigned char* xl, int wid, int lane) const {
        asm volatile("" : "+v"(lane)); fr = lane & 15; fq = lane >> 4;
        const int row0 = u.pm * BM + wr * 64 + fr, col0 = u.pn * HALF + wc * 32 + 8 * fq;
        const LAS float* RS_ = panel_rstd(pss, u.pm, xl, wid, lane);
#pragma unroll
        for (int ai = 0; ai < 2; ++ai)
#pragma unroll
            for (int m = 0; m < 4; ++m) { const int row = row0 + ai * HALF + m * 16; const float sc = RS_[ai * HALF + wr * 64 + m * 16 + fr];
                f32x4 o[2];
#pragma unroll
                for (int n = 0; n < 2; ++n)
#pragma unroll
                    for (int i = 0; i < 4; ++i) { const float gv = acc[ai][0][m][n][i] * sc, uv = acc[ai][1][m][n][i] * sc; o[n][i] = gv * sigmoid_f(gv) * uv; }
                *(GAS u32x4*)(O + (size_t)row * FF + col0) = pack8(o[0], o[1]); }
    }
};
struct EpiQKV {
    bf16_t *Q, *Kb, *Vb; const float *cosT, *sinT; const float* pss;
    __device__ __forceinline__ void operator()(const Acc& acc, const Unit& u, int wr, int wc, int fr, int fq, LAS unsigned char* xl, int wid, int lane) const {
        asm volatile("" : "+v"(lane)); fr = lane & 15; fq = lane >> 4;
        const int row0 = u.pm * BM + wr * 64 + fr;
        const LAS float* RS_ = panel_rstd(pss, u.pm, xl, wid, lane);
        if (u.pn < 5) {
            bf16_t* base; int ldc, colh;
            if (u.pn < 4) { base = Q; ldc = D; colh = (4 * u.pn + wc) * 64 + 8 * fq; } else { base = Kb; ldc = 256; colh = wc * 64 + 8 * fq; }
#pragma unroll
            for (int ai = 0; ai < 2; ++ai)
#pragma unroll
                for (int m = 0; m < 4; ++m) { const int row = row0 + ai * HALF + m * 16; const float sc = RS_[ai * HALF + wr * 64 + m * 16 + fr]; const int pos = row & (SEQ - 1);
                    const f32x4 c0 = *(const GAS f32x4*)(cosT + pos * 32 + 8 * fq), c1 = *(const GAS f32x4*)(cosT + pos * 32 + 8 * fq + 4);
                    const f32x4 s0 = *(const GAS f32x4*)(sinT + pos * 32 + 8 * fq), s1 = *(const GAS f32x4*)(sinT + pos * 32 + 8 * fq + 4);
                    const f32x4 a0 = acc[ai][0][m][0] * sc, a1 = acc[ai][0][m][1] * sc, b0 = acc[ai][1][m][0] * sc, b1 = acc[ai][1][m][1] * sc;
                    bf16_t* rowp = base + (size_t)row * ldc + colh;
                    *(GAS u32x4*)(rowp) = pack8(a0 * c0 - b0 * s0, a1 * c1 - b1 * s1);
                    *(GAS u32x4*)(rowp + 32) = pack8(b0 * c0 + a0 * s0, b1 * c1 + a1 * s1); }
        } else {
            const int col0 = wc * 32 + 8 * fq;
#pragma unroll
            for (int ai = 0; ai < 2; ++ai)
#pragma unroll
                for (int m = 0; m < 4; ++m) { const int row = row0 + ai * HALF + m * 16; const float sc = RS_[ai * HALF + wr * 64 + m * 16 + fr]; bf16_t* rowp = Vb + (size_t)row * 256 + col0;
#pragma unroll
                    for (int bj = 0; bj < 2; ++bj) *(GAS u32x4*)(rowp + bj * HALF) = pack8(acc[ai][bj][m][0] * sc, acc[ai][bj][m][1] * sc); }
        }
    }
};
template <bool SRC_F32> struct EpiNorm {
    const void* hsrc; bf16_t* HB; const float* g; float* pss; unsigned long long* xs; unsigned tag;
    __device__ __forceinline__ void operator()(const Acc& acc, const Unit& u, int wr, int wc, int fr, int fq, LAS unsigned char* xl, int wid, int lane) const {
        asm volatile("" : "+v"(lane)); fr = lane & 15; fq = lane >> 4;
        LAS float* P = (LAS float*)xl; LAS float* S = (LAS float*)(xl + 4096);
        const int col0 = u.pn * BM + wc * 32 + 8 * fq;
        u32x4 hpre[2][4][2];
        if (!SRC_F32) {
#pragma unroll
            for (int ai = 0; ai < 2; ++ai)
#pragma unroll
                for (int m = 0; m < 4; ++m)
#pragma unroll
                    for (int bj = 0; bj < 2; ++bj) hpre[ai][m][bj] = *(const GAS u32x4*)((const bf16_t*)hsrc + (size_t)(u.pm * BM + ai * HALF + wr * 64 + m * 16 + fr) * D + col0 + bj * HALF);
        }
#pragma unroll
        for (int ai = 0; ai < 2; ++ai)
#pragma unroll
            for (int m = 0; m < 4; ++m) { float ss = 0.f;
#pragma unroll
                for (int bj = 0; bj < 2; ++bj)
#pragma unroll
                    for (int n = 0; n < 2; ++n) { const f32x4 v = acc[ai][bj][m][n]; ss += (v[0] * v[0] + v[1] * v[1]) + (v[2] * v[2] + v[3] * v[3]); }
                ss += shx(ss, 16, lane); ss += shx(ss, 32, lane);
                if (fq == 0) P[(ai * HALF + wr * 64 + m * 16 + fr) * 4 + wc] = ss; }
        asm volatile("s_waitcnt lgkmcnt(0)" ::: "memory"); __builtin_amdgcn_s_barrier(); asm volatile("" ::: "memory");
        const int rl = wid * 32 + (lane & 31);
        if (lane < 32) {
            const f32x4 t4 = *(const LAS f32x4*)(P + rl * 4); const float s = (t4[0] + t4[1]) + (t4[2] + t4[3]);
            float v0 = s, v1 = s, v2 = s, v3 = s;
            unsigned long long* sl = xs + (size_t)(u.pm * BM + rl) * 4;
            __hip_atomic_store(sl + u.pn, ((unsigned long long)tag << 32) | (unsigned long long)__float_as_uint(s), __ATOMIC_RELAXED, __HIP_MEMORY_SCOPE_AGENT);
            unsigned done = 1u << u.pn, sp = 0;
            for (;;) {
#pragma unroll
                for (int t = 0; t < 4; ++t) if (!(done & (1u << t))) { const unsigned long long w = __hip_atomic_load(sl + t, __ATOMIC_RELAXED, __HIP_MEMORY_SCOPE_AGENT);
                    if ((unsigned)(w >> 32) == tag) { const float pv = __uint_as_float((unsigned)w); if (t == 0) v0 = pv; else if (t == 1) v1 = pv; else if (t == 2) v2 = pv; else v3 = pv; done |= 1u << t; } }
                if (__builtin_amdgcn_ballot_w64(done != 15u) == 0ull) break;
                if (++sp > (1u << 22)) break;
                __builtin_amdgcn_s_sleep(1);
            }
            S[rl] = rsqrtf(((v0 + v1) + (v2 + v3)) * (1.0f / D) + EPS);
        }
        asm volatile("s_waitcnt vmcnt(0) lgkmcnt(0)" ::: "memory"); __builtin_amdgcn_s_barrier(); asm volatile("" ::: "memory");
        f32x4 gv[2][2];
#pragma unroll
        for (int bj = 0; bj < 2; ++bj)
#pragma unroll
            for (int n = 0; n < 2; ++n) gv[bj][n] = *(const GAS f32x4*)(g + col0 + bj * HALF + 4 * n);
#pragma unroll
        for (int ai = 0; ai < 2; ++ai)
#pragma unroll
            for (int m = 0; m < 4; ++m) { const int rloc = ai * HALF + wr * 64 + m * 16 + fr; const float sr = S[rloc]; const int row = u.pm * BM + rloc; const size_t off = (size_t)row * D + col0; float ss = 0.f;
#pragma unroll
                for (int bj = 0; bj < 2; ++bj) {
                    f32x4 h0, h1;
                    if (SRC_F32) { h0 = *(const GAS f32x4*)((const float*)hsrc + off + bj * HALF); h1 = *(const GAS f32x4*)((const float*)hsrc + off + bj * HALF + 4); }
                    else { const u32x4 hw = hpre[ai][m][bj]; h0[0] = bf_lo(hw.x); h0[1] = bf_hi(hw.x); h0[2] = bf_lo(hw.y); h0[3] = bf_hi(hw.y); h1[0] = bf_lo(hw.z); h1[1] = bf_hi(hw.z); h1[2] = bf_lo(hw.w); h1[3] = bf_hi(hw.w); }
                    const f32x4 o0 = h0 + acc[ai][bj][m][0] * sr * gv[bj][0], o1 = h1 + acc[ai][bj][m][1] * sr * gv[bj][1];
                    ss += ((o0[0] * o0[0] + o0[1] * o0[1]) + (o0[2] * o0[2] + o0[3] * o0[3])) + ((o1[0] * o1[0] + o1[1] * o1[1]) + (o1[2] * o1[2] + o1[3] * o1[3]));
                    *(GAS u32x4*)(HB + off + bj * HALF) = pack8(o0, o1); }
                ss += shx(ss, 16, lane); ss += shx(ss, 32, lane);
                if (fq == 0) ((GAS float*)pss)[((size_t)u.pn * T + row) * 4 + wc] = ss;
                if (m & 1) asm volatile("" ::: "memory"); }
    }
};
template <bool LAST> struct EpiPle {
    const bf16_t* HX; bf16_t* HY; float* OUT; const bf16_t* PP; const float* pssa; float* pss;
    __device__ __forceinline__ void operator()(const Acc& acc, const Unit& u, int wr, int wc, int fr, int fq, LAS unsigned char* xl, int wid, int lane) const {
        asm volatile("" : "+v"(lane)); fr = lane & 15; fq = lane >> 4;
        const int row0 = u.pm * BM + wr * 64 + fr, col0 = u.pn * BM + wc * 32 + 8 * fq;
        const LAS float* RS_ = panel_rstd(pssa, u.pm, xl, wid, lane);
#pragma unroll
        for (int ai = 0; ai < 2; ++ai) {
            u32x4 hq[4][2], pq[4][2]; float scq[4];
#pragma unroll
            for (int m = 0; m < 4; ++m) { scq[m] = RS_[ai * HALF + wr * 64 + m * 16 + fr];
#pragma unroll
                for (int bj = 0; bj < 2; ++bj) { const size_t off = (size_t)(row0 + ai * HALF + m * 16) * D + col0 + bj * HALF; hq[m][bj] = *(const GAS u32x4*)(HX + off); pq[m][bj] = *(const GAS u32x4*)(PP + off); } }
            asm volatile("s_waitcnt vmcnt(0) lgkmcnt(0)" : "+v"(hq[0][0]), "+v"(hq[3][1]), "+v"(pq[0][0]), "+v"(pq[3][1]) :: "memory");
#pragma unroll
            for (int m = 0; m < 4; ++m) { const int row = row0 + ai * HALF + m * 16; const float sc = scq[m]; const size_t off = (size_t)row * D + col0; float ss = 0.f;
#pragma unroll
                for (int bj = 0; bj < 2; ++bj) {
                    const u32x4 hw = hq[m][bj]; const u32x4 pw = pq[m][bj];
                    f32x4 h0, h1, p0, p1;
                    h0[0] = bf_lo(hw.x); h0[1] = bf_hi(hw.x); h0[2] = bf_lo(hw.y); h0[3] = bf_hi(hw.y); h1[0] = bf_lo(hw.z); h1[1] = bf_hi(hw.z); h1[2] = bf_lo(hw.w); h1[3] = bf_hi(hw.w);
                    p0[0] = bf_lo(pw.x); p0[1] = bf_hi(pw.x); p0[2] = bf_lo(pw.y); p0[3] = bf_hi(pw.y); p1[0] = bf_lo(pw.z); p1[1] = bf_hi(pw.z); p1[2] = bf_lo(pw.w); p1[3] = bf_hi(pw.w);
                    f32x4 o0, o1;
#pragma unroll
                    for (int i = 0; i < 4; ++i) { o0[i] = h0[i] + p0[i] * sigmoid_f(acc[ai][bj][m][0][i] * sc); o1[i] = h1[i] + p1[i] * sigmoid_f(acc[ai][bj][m][1][i] * sc); ss += o0[i] * o0[i] + o1[i] * o1[i]; }
                    if (LAST) { *(GAS f32x4*)(OUT + off + bj * HALF) = o0; *(GAS f32x4*)(OUT + off + bj * HALF + 4) = o1; }
                    else *(GAS u32x4*)(HY + off + bj * HALF) = pack8(o0, o1); }
                if (!LAST) { ss += shx(ss, 16, lane); ss += shx(ss, 32, lane);
                    if (fq == 0) ((GAS float*)pss)[((size_t)u.pn * T + row) * 4 + wc] = ss; } }
            asm volatile("" ::: "memory"); }
    }
};
}

struct Job { const float* W; const float* gk; const float* gn; bf16_t* dst; int K, N, mode; float cs; };
constexpr int NJOBS = 34;
struct Args { const float* in[20]; float* out; unsigned char* ws; Job jobs[NJOBS]; };

__device__ __forceinline__ int dest_row(int mode, int n) {
    if (mode == 0) return n;
    if (mode == 1) return (n >> 7) * 256 + (n & 127);
    if (mode == 2) return (n >> 7) * 256 + 128 + (n & 127);
    const int head = n >> 6, d = n & 63; return (head >> 2) * 256 + (d >> 5) * 128 + (head & 3) * 32 + (d & 31);
}
__device__ __forceinline__ void wconv_item(const float* W, const float* gk, const float* gn, bf16_t* dst, int K, int N, int mode, float cs, LAS float* scr, int item, int lane) {
    const int nblk = N / 32, kb = item / nblk, nb = item % nblk, k0 = 64 * kb, n0 = 32 * nb;
    float wv[32];
#pragma unroll
    for (int i = 0; i < 32; ++i) wv[i] = ((const GAS float*)W)[(size_t)(k0 + 2 * i + (lane >> 5)) * N + n0 + (lane & 31)];
    if (gk) {
#pragma unroll
        for (int i = 0; i < 32; ++i) wv[i] *= ((const GAS float*)gk)[k0 + 2 * i + (lane >> 5)]; }
#pragma unroll
    for (int i = 0; i < 32; ++i) scr[(2 * i + (lane >> 5)) * 33 + (lane & 31)] = wv[i];
    asm volatile("s_waitcnt lgkmcnt(0)" ::: "memory");
    const int c = lane & 7;
#pragma unroll
    for (int j = 0; j < 4; ++j) { const int n = (lane >> 3) + 8 * j; const LAS float* s = scr + (8 * c) * 33 + n; const float sc = gn ? cs * ((const GAS float*)gn)[n0 + n] : cs;
        u32x4 o; o.x = cvt_pk_bf16(s[0 * 33] * sc, s[1 * 33] * sc); o.y = cvt_pk_bf16(s[2 * 33] * sc, s[3 * 33] * sc); o.z = cvt_pk_bf16(s[4 * 33] * sc, s[5 * 33] * sc); o.w = cvt_pk_bf16(s[6 * 33] * sc, s[7 * 33] * sc);
        *(GAS u32x4*)(dst + (size_t)dest_row(mode, n0 + n) * K + k0 + 8 * c) = o; }
    asm volatile("s_waitcnt lgkmcnt(0)" ::: "memory");
}
__device__ __forceinline__ void wconv_load(const float* W, const float* gk, int N, int item, int lane, float (&wv)[32], float (&gv)[32]) {
    const int nblk = N / 32, kb = item / nblk, nb = item % nblk, k0 = 64 * kb, n0 = 32 * nb;
#pragma unroll
    for (int i = 0; i < 32; ++i) wv[i] = ((const GAS float*)W)[(size_t)(k0 + 2 * i + (lane >> 5)) * N + n0 + (lane & 31)];
#pragma unroll
    for (int i = 0; i < 32; ++i) gv[i] = gk ? ((const GAS float*)gk)[k0 + 2 * i + (lane >> 5)] : 1.0f;
}
__device__ __forceinline__ void wconv_finish(const float* gn, bf16_t* dst, int K, int N, int mode, float cs, LAS float* scr, int item, int lane, const float (&wv)[32], const float (&gv)[32]) {
    const int nblk = N / 32, kb = item / nblk, nb = item % nblk, k0 = 64 * kb, n0 = 32 * nb;
#pragma unroll
    for (int i = 0; i < 32; ++i) scr[(2 * i + (lane >> 5)) * 33 + (lane & 31)] = wv[i] * gv[i];
    asm volatile("s_waitcnt lgkmcnt(0)" ::: "memory");
    const int c = lane & 7;
#pragma unroll
    for (int j = 0; j < 4; ++j) { const int n = (lane >> 3) + 8 * j; const LAS float* s = scr + (8 * c) * 33 + n; const float sc = gn ? cs * ((const GAS float*)gn)[n0 + n] : cs;
        u32x4 o; o.x = cvt_pk_bf16(s[0 * 33] * sc, s[1 * 33] * sc); o.y = cvt_pk_bf16(s[2 * 33] * sc, s[3 * 33] * sc); o.z = cvt_pk_bf16(s[4 * 33] * sc, s[5 * 33] * sc); o.w = cvt_pk_bf16(s[6 * 33] * sc, s[7 * 33] * sc);
        *(GAS u32x4*)(dst + (size_t)dest_row(mode, n0 + n) * K + k0 + 8 * c) = o; }
    asm volatile("s_waitcnt lgkmcnt(0)" ::: "memory");
}
__device__ __forceinline__ void conv_p(const float* p, bf16_t* pb, int gtid, int nthr) {
    constexpr int NV = T * PLE / 8;
    for (int i = gtid; i < NV; i += 2 * nthr) { const int i2 = (i + nthr < NV) ? i + nthr : i;
        const f32x4 a = *(const GAS f32x4*)(p + (size_t)i * 8), b = *(const GAS f32x4*)(p + (size_t)i * 8 + 4), c = *(const GAS f32x4*)(p + (size_t)i2 * 8), d = *(const GAS f32x4*)(p + (size_t)i2 * 8 + 4);
        *(GAS u32x4*)(pb + (size_t)i * 8) = pg8::pack8(a, b); *(GAS u32x4*)(pb + (size_t)i2 * 8) = pg8::pack8(c, d); }
}

template <int W, bool SRC_F32>
__device__ __forceinline__ void pool_cols(const void* h, float gx, float gy, bf16_t* pooled, const LAS float* rsl, int first, int t0, int s0, int c) {
    f32x2 ring[16];
#pragma unroll
    for (int i = 0; i < 16; ++i) ring[i] = (f32x2){0.f, 0.f};
    float Sx = 0.f, Sy = 0.f;
    for (int tb = first; tb < t0 + 128; tb += 16) {
        f32x2 v[16];
#pragma unroll
        for (int i = 0; i < 16; ++i) { if (SRC_F32) v[i] = *(const GAS f32x2*)((const float*)h + (size_t)(tb + i) * D + c);
            else { const unsigned w = *(const GAS unsigned*)((const bf16_t*)h + (size_t)(tb + i) * D + c); v[i] = (f32x2){bf_lo(w), bf_hi(w)}; } }
        const bool emit = tb >= t0;
#pragma unroll
        for (int i = 0; i < 16; ++i) {
            const float r = rsl[tb + i - first]; const float hx = v[i].x * r * gx, hy = v[i].y * r * gy;
            Sx += hx - ring[(i - W) & 15].x; Sy += hy - ring[(i - W) & 15].y; ring[i] = (f32x2){hx, hy};
            if (emit) { const int s = s0 + (tb + i - t0); const int cnt = (s + 1 < W) ? s + 1 : W; const float inv = 1.0f / (float)cnt;
                *(GAS unsigned*)(pooled + (size_t)(tb + i) * D + c) = cvt_pk_bf16(Sx * inv - hx, Sy * inv - hy); }
        }
    }
}
template <bool SRC_F32>
__device__ __forceinline__ void pool_prep(const void* h, const float* gpre, bf16_t* pooled, LAS unsigned char* lds, int tid, int wave, int lane, const float* pss = nullptr) {
    LAS float* rsl = (LAS float*)lds;
    for (int run = blockIdx.x; run < T / 128; run += gridDim.x) {
        const int t0 = run * 128, s0 = t0 & (SEQ - 1), first = (s0 == 0) ? t0 : t0 - 16, nrows = t0 + 128 - first;
        if (!SRC_F32) { for (int r = tid; r < nrows; r += NTHREADS) rsl[r] = pg8::rstd_from_pss(pss, first + r); }
        else
        for (int rb = wave; rb < nrows; rb += 4 * NWAVES) {
            float ss[4];
            if (SRC_F32) { f32x4 v[4][4];
#pragma unroll
                for (int q = 0; q < 4; ++q) { const int r = (rb + NWAVES * q < nrows) ? rb + NWAVES * q : nrows - 1; const GAS f32x4* xr = (const GAS f32x4*)((const float*)h + (size_t)(first + r) * D) + lane;
#pragma unroll
                    for (int j = 0; j < 4; ++j) v[q][j] = xr[64 * j]; }
#pragma unroll
                for (int q = 0; q < 4; ++q) { float s = 0.f;
#pragma unroll
                    for (int j = 0; j < 4; ++j) s += (v[q][j][0] * v[q][j][0] + v[q][j][1] * v[q][j][1]) + (v[q][j][2] * v[q][j][2] + v[q][j][3] * v[q][j][3]);
                    ss[q] = s; } }
            else { ss[0] = ss[1] = ss[2] = ss[3] = 0.f; }
#pragma unroll
            for (int q = 0; q < 4; ++q) { const float s = wave_sum(ss[q], lane); const int r = rb + NWAVES * q; if (lane == 0 && r < nrows) rsl[r] = rsqrtf(s * (1.0f / D) + EPS); } }
        __syncthreads();
        const int c = 2 * tid, grp = tid >> 7; const float gx = ((const GAS float*)gpre)[c], gy = ((const GAS float*)gpre)[c + 1];
        if (grp == 0) pool_cols<2, SRC_F32>(h, gx, gy, pooled, rsl, first, t0, s0, c);
        else if (grp == 1) pool_cols<4, SRC_F32>(h, gx, gy, pooled, rsl, first, t0, s0, c);
        else if (grp == 2) pool_cols<8, SRC_F32>(h, gx, gy, pooled, rsl, first, t0, s0, c);
        else pool_cols<16, SRC_F32>(h, gx, gy, pooled, rsl, first, t0, s0, c);
        __syncthreads();
    }
}

__device__ __forceinline__ int crow(int r, int hi) { return (r & 3) + 8 * (r >> 2) + 4 * hi; }
constexpr int A_KOFF = 0, A_VOFF = 32768;
__device__ __forceinline__ void attn_load_kv(int u, const bf16_t* Kb, const bf16_t* Vb, u32x4 (&kw)[4], u32x4 (&vw)[4], int tid) {
    const int n = u & 127, bk = u >> 7, b = bk >> 2, kvh = bk & 3; const long kt0 = (long)b * SEQ + (long)n * 128 - 128;
#pragma unroll
    for (int i = 0; i < 4; ++i) { const int cidx = tid + 512 * i, kv = cidx >> 3, ch = cidx & 7;
        const bool ok = (n > 0 || kv >= 128); const unsigned msk = ok ? 0xffffffffu : 0u; const int kvs = ok ? kv : kv + 128;
        kw[i] = *(const GAS u32x4*)(Kb + (size_t)(kt0 + kvs) * 256 + kvh * 64 + ch * 8) & msk; vw[i] = *(const GAS u32x4*)(Vb + (size_t)(kt0 + kvs) * 256 + kvh * 64 + ch * 8) & msk; }
}
__device__ __forceinline__ void attn_phase(const bf16_t* Q, const bf16_t* Kb, const bf16_t* Vb, bf16_t* O, const float* sinks, LAS unsigned char* lds, int G, int tid, int wave, int lane) {
    const int r32 = lane & 31, hi = lane >> 5;
    int u = blockIdx.x; if (u >= 1024) return;
    u32x4 kw[4], vw[4]; attn_load_kv(u, Kb, Vb, kw, vw, tid);
    const float NEG = -__builtin_inff();
    for (; u < 1024; u += G) {
        const int n = u & 127, bk = u >> 7, b = bk >> 2, kvh = bk & 3; const long tok0 = (long)b * SEQ + (long)n * 128;
        const int head = kvh * 4 + (wave >> 1);
#pragma unroll
        for (int i = 0; i < 4; ++i) { const int cidx = tid + 512 * i, kv = cidx >> 3, ch = cidx & 7;
            *(LAS u32x4*)(lds + A_KOFF + kv * 128 + ((ch ^ ((kv >> 1) & 7)) << 4)) = kw[i];
            *(LAS u32x4*)(lds + A_VOFF + (ch >> 2) * 16384 + kv * 64 + (ch & 3) * 16) = vw[i]; }
        __syncthreads();
        if (u + G < 1024) attn_load_kv(u + G, Kb, Vb, kw, vw, tid);
        const float sink2 = ((const GAS float*)sinks)[head] * LOG2E;
#pragma unroll
        for (int it = 0; it < 2; ++it) {
            const int r0 = ((wave & 1) * 2 + it) * 32, jt0 = r0 >> 5;
            bf16x8 qf[4]; { const bf16_t* qp = Q + (size_t)(tok0 + r0 + r32) * D + head * 64 + hi * 8;
#pragma unroll
                for (int d0 = 0; d0 < 4; ++d0) qf[d0] = *(const GAS bf16x8*)(qp + d0 * 16); }
            f32x16 p[5];
            bf16x8 kf[2][4];
#define ATT_LDK(buf, j_) do { const int kvrow_ = (jt0 + (j_)) * 32 + r32; _Pragma("unroll") for (int d0 = 0; d0 < 4; ++d0) { const int ch_ = 2 * d0 + hi; \
                kf[buf][d0] = *(const LAS bf16x8*)(lds + A_KOFF + kvrow_ * 128 + ((ch_ ^ ((kvrow_ >> 1) & 7)) << 4)); } } while (0)
            ATT_LDK(0, 0);
#pragma unroll
            for (int j = 0; j < 5; ++j) {
                if (j < 4) ATT_LDK((j + 1) & 1, j + 1);
                const f32x16 zero16 = {0.f, 0.f, 0.f, 0.f, 0.f, 0.f, 0.f, 0.f, 0.f, 0.f, 0.f, 0.f, 0.f, 0.f, 0.f, 0.f};
                f32x16 c0 = zero16;
                if (j == 0 || j == 4) { int rl_ = r32; asm volatile("" : "+v"(rl_));
#pragma unroll
                    for (int r = 0; r < 16; ++r) c0[r] = ((j == 0) ? (crow(r, hi) <= rl_) : (crow(r, hi) > rl_)) ? NEG : 0.f; }
                p[j] = __builtin_amdgcn_mfma_f32_32x32x16_bf16(kf[j & 1][0], qf[0], c0, 0, 0, 0);
#pragma unroll
                for (int d0 = 1; d0 < 4; ++d0) p[j] = __builtin_amdgcn_mfma_f32_32x32x16_bf16(kf[j & 1][d0], qf[d0], p[j], 0, 0, 0); }
#undef ATT_LDK
            if (n == 0) {
#pragma unroll
                for (int j = 0; j < 5; ++j) if (jt0 + j < 4) {
#pragma unroll
                    for (int r = 0; r < 16; ++r) p[j][r] = NEG; }
            }
            float mx = sink2;
#pragma unroll
            for (int j = 0; j < 5; ++j)
#pragma unroll
                for (int r = 0; r < 16; ++r) mx = fmaxf(mx, p[j][r]);
            mx = fmaxf(mx, shx(mx, 32, lane));
            float sum = 0.f;
#pragma unroll
            for (int j = 0; j < 5; ++j)
#pragma unroll
                for (int r = 0; r < 16; ++r) { const float e = __builtin_amdgcn_exp2f(p[j][r] - mx); p[j][r] = e; sum += e; }
            sum += shx(sum, 32, lane);
            sum += __builtin_amdgcn_exp2f(sink2 - mx);
            const float inv = 1.0f / sum;
            f32x16 o[2];
            s16x4 vlo[2][2], vh8[2][2];
            LAS unsigned char* vbase = lds + A_VOFF + (jt0 * 32 + 4 * hi + ((lane >> 2) & 3)) * 64 + ((lane >> 4) & 1) * 32 + (lane & 3) * 8;
#define ATT_LDV(buf, t_) do { _Pragma("unroll") for (int dh = 0; dh < 2; ++dh) { LAS unsigned char* va_ = vbase + dh * 16384 + (t_) * 1024; \
                vlo[buf][dh] = __builtin_bit_cast(s16x4, __builtin_amdgcn_ds_read_tr16_b64_v4i16((LAS s16x4*)va_)); vh8[buf][dh] = __builtin_bit_cast(s16x4, __builtin_amdgcn_ds_read_tr16_b64_v4i16((LAS s16x4*)(va_ + 512))); } } while (0)
            ATT_LDV(0, 0);
#pragma unroll
            for (int t = 0; t < 10; ++t) { const int j = t >> 1, s = t & 1;
                if (t < 9) ATT_LDV((t + 1) & 1, t + 1);
                u32x4 pw; pw.x = cvt_pk_bf16(p[j][8 * s + 0], p[j][8 * s + 1]); pw.y = cvt_pk_bf16(p[j][8 * s + 2], p[j][8 * s + 3]);
                pw.z = cvt_pk_bf16(p[j][8 * s + 4], p[j][8 * s + 5]); pw.w = cvt_pk_bf16(p[j][8 * s + 6], p[j][8 * s + 7]);
                const bf16x8 pf = __builtin_bit_cast(bf16x8, pw);
#pragma unroll
                for (int dh = 0; dh < 2; ++dh) { const s16x4 lo = vlo[t & 1][dh], h8 = vh8[t & 1][dh];
                    const bf16x8 vf = (bf16x8){lo[0], lo[1], lo[2], lo[3], h8[0], h8[1], h8[2], h8[3]};
                    const f32x16 zero16 = {0.f, 0.f, 0.f, 0.f, 0.f, 0.f, 0.f, 0.f, 0.f, 0.f, 0.f, 0.f, 0.f, 0.f, 0.f, 0.f};
                    o[dh] = __builtin_amdgcn_mfma_f32_32x32x16_bf16(vf, pf, t == 0 ? zero16 : o[dh], 0, 0, 0); } }
#undef ATT_LDV
            bf16_t* op = O + (size_t)(tok0 + r0 + r32) * D + head * 64 + 4 * hi;
#pragma unroll
            for (int dh = 0; dh < 2; ++dh)
#pragma unroll
                for (int gq = 0; gq < 4; ++gq) { u32x2 w; w.x = cvt_pk_bf16(o[dh][4 * gq] * inv, o[dh][4 * gq + 1] * inv); w.y = cvt_pk_bf16(o[dh][4 * gq + 2] * inv, o[dh][4 * gq + 3] * inv); *(GAS u32x2*)(op + 32 * dh + 8 * gq) = w; }
        }
        __syncthreads();
    }
}

#define XB_TMO      128
#define XB_XCNT(j)  (256  + 64 * (j))
#define XB_XSUB(j)  (1280 + 64 * (j))
#define XB_XGEN(j)  (2304 + 64 * (j))
#define XB_TOP      3328
#define XB_TOPGEN   3392
#define XCD_BAR_WORDS 3456
#define XB_SPIN_CAP (1u << 22)
__device__ __forceinline__ unsigned xb_ld(unsigned* p)              { return __hip_atomic_load(p, __ATOMIC_RELAXED, __HIP_MEMORY_SCOPE_AGENT); }
__device__ __forceinline__ unsigned xb_add(unsigned* p, unsigned v) { return __hip_atomic_fetch_add(p, v, __ATOMIC_RELAXED, __HIP_MEMORY_SCOPE_AGENT); }
__device__ __forceinline__ unsigned xb_xcc_id() { return (unsigned)__builtin_amdgcn_s_getreg((3 << 11) | 20) & 0xFu; }
#define XB_SPIN(cond, bar) do { unsigned _sp = 0; while (cond) { __builtin_amdgcn_s_sleep(1); \
    if ((++_sp & 255u) == 0u) { if (xb_ld(&(bar)[XB_TMO])) break; if (_sp > XB_SPIN_CAP) { atomicAdd(&(bar)[XB_TMO], 1u); break; } } } } while (0)
struct XcdBarrier { unsigned* bar; unsigned x; volatile LAS unsigned* st; };
__device__ __forceinline__ XcdBarrier xcd_barrier_post(unsigned* bar, volatile LAS unsigned* st) {
    XcdBarrier b; b.bar = bar; b.x = 0; b.st = st;
    if (threadIdx.x == 0) (void)xb_add(&bar[XB_XCNT(xb_xcc_id())], 1u);
    return b;
}
__device__ __forceinline__ void xcd_barrier_complete(unsigned* bar, unsigned x, unsigned& nloc, unsigned& nx) {
    const unsigned G = gridDim.x * gridDim.y * gridDim.z;
    unsigned sum, cnt, mine, sp = 0u;
    for (;;) {
        sum = 0u; cnt = 0u; mine = 0u;
#pragma unroll
        for (unsigned j = 0; j < 16; ++j) { const unsigned c = xb_ld(&bar[XB_XCNT(j)]); sum += c; cnt += (c > 0u) ? 1u : 0u; mine = (j == x) ? c : mine; }
        if (sum == G) break;
        __builtin_amdgcn_s_sleep(1);
        if ((++sp & 255u) == 0u) { if (xb_ld(&bar[XB_TMO])) break; if (sp > XB_SPIN_CAP) { atomicAdd(&bar[XB_TMO], 1u); break; } }
    }
    nloc = mine > 0u ? mine : 1u; nx = cnt > 0u ? cnt : 1u;
}
__device__ __forceinline__ void xcd_barrier(const XcdBarrier& b, int wave_s) {
    asm volatile("s_waitcnt vmcnt(0) lgkmcnt(0)" ::: "memory");
    __syncthreads();
    unsigned m1_ = ~0u; asm volatile("" : "+s"(m1_));
    if (wave_s == 0 && __builtin_amdgcn_mbcnt_hi(m1_, __builtin_amdgcn_mbcnt_lo(m1_, 0u)) == 0u) {
        unsigned* bar = b.bar; asm volatile("" : "+s"(bar)); const unsigned bx = xb_xcc_id();
        __builtin_amdgcn_s_waitcnt(0);
        unsigned nloc = b.st[0], nx = b.st[1];
        if (nloc == 0u) { xcd_barrier_complete(bar, bx, nloc, nx); b.st[0] = nloc; b.st[1] = nx; }
        const unsigned old = xb_add(&bar[XB_XSUB(bx)], 1u);
        const unsigned gen = old / nloc;
        if (old + 1u == (gen + 1u) * nloc) {
            __builtin_amdgcn_fence(__ATOMIC_RELEASE, "agent");
            asm volatile("s_waitcnt vmcnt(0)" ::: "memory");
            const unsigned og = xb_add(&bar[XB_TOP], 1u);
            const unsigned tg = og / nx;
            if (og + 1u == (tg + 1u) * nx) {
                xb_add(&bar[XB_TOPGEN], 1u); xb_add(&bar[XB_XGEN(bx)], 1u);
                __builtin_amdgcn_fence(__ATOMIC_ACQUIRE, "agent"); asm volatile("s_waitcnt vmcnt(0)" ::: "memory");
            } else {
                __builtin_amdgcn_fence(__ATOMIC_ACQUIRE, "agent"); asm volatile("s_waitcnt vmcnt(0)" ::: "memory");
                XB_SPIN(xb_ld(&bar[XB_TOPGEN]) == tg, bar);
                xb_add(&bar[XB_XGEN(bx)], 1u);
            }
        } else {
            __builtin_amdgcn_fence(__ATOMIC_ACQUIRE, "agent");
            asm volatile("s_waitcnt vmcnt(0)" ::: "memory");
            XB_SPIN(xb_ld(&bar[XB_XGEN(bx)]) == gen, bar);
        }
    }
    __syncthreads();
}
struct Ctx {
    int tid, lane, wave, G, gw, ngw, gtid, nthr;
    bf16_t *Wb, *HB, *MB, *ACT, *ATT, *KB, *VB, *PB, *PP; float *COS, *SIN, *PSSA, *PSSB; unsigned long long* XS;
};
__device__ __forceinline__ Ctx make_ctx(unsigned char* ws_in, int tid) {
    unsigned char* ws = (unsigned char*)(GAS unsigned char*)ws_in;
    Ctx c; c.tid = tid; c.lane = tid & 63; c.wave = __builtin_amdgcn_readfirstlane(tid >> 6); c.G = gridDim.x;
    c.gw = blockIdx.x * NWAVES + c.wave; c.ngw = c.G * NWAVES; c.gtid = blockIdx.x * NTHREADS + tid; c.nthr = c.G * NTHREADS;
    c.Wb = (bf16_t*)(ws + WS_W); c.HB = (bf16_t*)(ws + WS_HB); c.MB = (bf16_t*)(ws + WS_MB); c.ACT = (bf16_t*)(ws + WS_ACT); c.ATT = (bf16_t*)(ws + WS_ACT + 64 * MiB);
    c.KB = (bf16_t*)(ws + WS_K); c.VB = (bf16_t*)(ws + WS_V); c.PB = (bf16_t*)(ws + WS_PB);
    c.COS = (float*)(ws + WS_COS); c.SIN = (float*)(ws + WS_SIN); c.PSSA = (float*)(ws + WS_PSSA); c.PSSB = (float*)(ws + WS_PSSB); c.PP = (bf16_t*)(ws + WS_PP);
    c.XS = (unsigned long long*)(ws + WS_XS);
    return c;
}
#define GRID_SYNC() do { xcd_barrier(xbar, wave_s); } while (0)
#define PHASE_BEGIN() unsigned m1_ = ~0u; asm volatile("" : "+s"(m1_)); int tid_p = wave_s * 64 + (int)__builtin_amdgcn_mbcnt_hi(m1_, __builtin_amdgcn_mbcnt_lo(m1_, 0u)); asm volatile("" : "+s"(ws_s)); const Ctx C = make_ctx(ws_s, tid_p)
#define INP(k) ({ int kk_ = (k); asm volatile("" : "+s"(kk_)); (const float*)(GAS const float*)args.in[kk_]; })

__global__ void __launch_bounds__(NTHREADS, 2) mk_fwd(Args args) {
    extern __shared__ __attribute__((aligned(16))) unsigned char lds_raw[];
    LAS unsigned char* lds = (LAS unsigned char*)lds_raw;
    cg::grid_group grid = cg::this_grid();
    unsigned char* ws_s = args.ws;
    unsigned xuse = 0;
    int wave_s = __builtin_amdgcn_readfirstlane(threadIdx.x >> 6);
    volatile LAS unsigned* xst = (volatile LAS unsigned*)(lds + 131072 + 12288);
    if (threadIdx.x < 2) xst[threadIdx.x] = 0u;
    __syncthreads();
    const XcdBarrier xbar = xcd_barrier_post((unsigned*)(args.ws + WS_BAR), xst);
    if (__builtin_expect(args.ws == nullptr, 0)) grid.sync();
    float* H = (float*)(GAS float*)args.out;

    {
        PHASE_BEGIN();
        LAS float* scr = (LAS float*)(lds + C.wave * 16384);
        {
            int jn = 0, basen = 0, g = C.gw;
#define WC_LOCATE(found_) do { found_ = false; while (jn < NJOBS) { const int n_ = (args.jobs[jn].K / 64) * (args.jobs[jn].N / 32); if (g < basen + n_) { found_ = true; break; } basen += n_; ++jn; } } while (0)
            bool hc; WC_LOCATE(hc);
            float wa[32], ga[32], wb[32], gb[32];
            int jc = jn, ic = g - basen;
            if (hc) wconv_load(args.jobs[jc].W, args.jobs[jc].gk, args.jobs[jc].N, ic, C.lane, wa, ga);
            while (hc) {
                g += C.ngw; bool hn; WC_LOCATE(hn);
                const int jx = jn, ix = g - basen;
                if (hn) wconv_load(args.jobs[jx].W, args.jobs[jx].gk, args.jobs[jx].N, ix, C.lane, wb, gb);
                wconv_finish(args.jobs[jc].gn, args.jobs[jc].dst, args.jobs[jc].K, args.jobs[jc].N, args.jobs[jc].mode, args.jobs[jc].cs, scr, ic, C.lane, wa, ga);
#pragma unroll
                for (int i = 0; i < 32; ++i) { wa[i] = wb[i]; ga[i] = gb[i]; }
                jc = jx; ic = ix; hc = hn;
            }
#undef WC_LOCATE
        }
        for (int i = C.gtid; i < SEQ * 32; i += C.nthr) { const int pos = i >> 5, dd = i & 31;
            const float inv = __builtin_amdgcn_exp2f(-(float)dd * 0.41524101186092029f);
            const double rev = (double)pos * (double)inv * 0.15915494309189535; const float f = (float)(rev - __builtin_floor(rev));
            ((GAS float*)C.COS)[i] = __builtin_amdgcn_cosf(f); ((GAS float*)C.SIN)[i] = __builtin_amdgcn_sinf(f); }
        conv_p(INP(1), C.PB, C.gtid, C.nthr);
        __syncthreads();
        pool_prep<true>(INP(0), INP(2), C.ACT, lds, C.tid, C.wave, C.lane);
    }
    GRID_SYNC();

#pragma nounroll
    for (int L = 0; L < 4; ++L) {
        if (L < 2) {
            if (L == 1) { PHASE_BEGIN(); conv_p(INP(1) + (size_t)L * T * PLE, C.PB, C.gtid, C.nthr); pool_prep<false>(C.MB, INP(2) + L * D, C.ACT, lds, C.tid, C.wave, C.lane, C.PSSB); GRID_SYNC(); }
            { PHASE_BEGIN(); ++xuse; pg8::Gemm g{C.ACT, C.Wb + W_POOL + L * W_POOL_SZ, D, 256, 256}; pg8::StaticOrder S; S.init(T, D, C.G, blockIdx.x);
              if (L == 0) { pg8::EpiNorm<true> E{INP(0), C.HB, INP(3) + L * D, C.PSSA, C.XS, xuse}; pg8::gemm_phase(lds, g, S, E, C.tid); }
              else { pg8::EpiNorm<false> E{C.MB, C.HB, INP(3) + L * D, C.PSSA, C.XS, xuse}; pg8::gemm_phase(lds, g, S, E, C.tid); } }
            GRID_SYNC();
        } else {
            const int j = L - 2;
            { PHASE_BEGIN(); conv_p(INP(1) + (size_t)L * T * PLE, C.PB, C.gtid, C.nthr);
              pg8::Gemm g{C.MB, j == 0 ? C.Wb + W_QKV : C.Wb + W_Q3, D, D, 0}; pg8::StaticOrder S; S.init(T, j == 0 ? 1536 : D, C.G, blockIdx.x);
              pg8::EpiQKV E{C.ACT, C.KB, C.VB, C.COS, C.SIN, C.PSSB}; pg8::gemm_phase(lds, g, S, E, C.tid); }
            GRID_SYNC();
            { PHASE_BEGIN(); const float* sinks = INP(13) + j * 16;
              attn_phase(C.ACT, C.KB, C.VB, C.ATT, sinks, lds, C.G, C.tid, C.wave, C.lane); }
            GRID_SYNC();
            { PHASE_BEGIN(); ++xuse; pg8::Gemm g{C.ATT, C.Wb + W_O + (size_t)j * D * D, D, D, 0}; pg8::StaticOrder S; S.init(T, D, C.G, blockIdx.x);
              pg8::EpiNorm<false> E{C.MB, C.HB, INP(3) + L * D, C.PSSA, C.XS, xuse}; pg8::gemm_phase(lds, g, S, E, C.tid); }
            GRID_SYNC();
        }
        { PHASE_BEGIN(); pg8::Gemm g{C.HB, C.Wb + W_GU + L * W_GU_SZ, D, D, 0}; pg8::StaticOrder S; S.init(T, 2 * FF, C.G, blockIdx.x);
          pg8::EpiSwiglu E{C.ACT, C.PSSA}; pg8::gemm_phase(lds, g, S, E, C.tid); }
        { PHASE_BEGIN(); pg8::Gemm g{C.PB, C.Wb + W_PP + L * W_PP_SZ, PLE, PLE, 0}; pg8::StaticOrder S; S.init(T, D, C.G, blockIdx.x);
          pg8::EpiPlain E{C.PP, D, nullptr}; pg8::gemm_phase(lds, g, S, E, C.tid); }
        GRID_SYNC();
        { PHASE_BEGIN(); ++xuse; pg8::Gemm g{C.ACT, C.Wb + W_D + L * W_D_SZ, FF, FF, 0}; pg8::StaticOrder S; S.init(T, D, C.G, blockIdx.x);
          pg8::EpiNorm<false> E{C.HB, C.HB, INP(5) + L * D, C.PSSA, C.XS, xuse}; pg8::gemm_phase(lds, g, S, E, C.tid); }
        GRID_SYNC();
        { PHASE_BEGIN(); pg8::Gemm g{C.HB, C.Wb + W_PG + L * W_PG_SZ, D, D, 0}; pg8::StaticOrder S; S.init(T, D, C.G, blockIdx.x);
          if (L < 3) { pg8::EpiPle<false> E{C.HB, C.MB, H, C.PP, C.PSSA, C.PSSB}; pg8::gemm_phase(lds, g, S, E, C.tid); }
          else { pg8::EpiPle<true> E{C.HB, C.MB, H, C.PP, C.PSSA, C.PSSB}; pg8::gemm_phase(lds, g, S, E, C.tid); } }
        if (L < 3) GRID_SYNC();
    }
}

extern "C" void kernel_launch(void* const* d_in, const int* in_sizes, int n_in, void* d_out, int out_size, void* d_ws, size_t ws_size, hipStream_t stream) {
    static int grid = 0;
    if (grid == 0) {
        if (n_in != 20 || out_size != T * D || ws_size < WS_END) { fprintf(stderr, "kernel_launch: unexpected shapes (n_in %d out %d ws %zu)\n", n_in, out_size, ws_size); grid = -1; return; }
        int dev = 0, cus = 0, per_cu = 0;
        hipGetDevice(&dev); hipDeviceGetAttribute(&cus, hipDeviceAttributeMultiprocessorCount, dev);
        hipFuncSetAttribute((const void*)mk_fwd, hipFuncAttributeMaxDynamicSharedMemorySize, LDS_BYTES);
        if (hipOccupancyMaxActiveBlocksPerMultiprocessor(&per_cu, (const void*)mk_fwd, NTHREADS, LDS_BYTES) != hipSuccess || per_cu < 1) per_cu = 1;
        (void)hipGetLastError();
        grid = cus * per_cu;
    }
    if (grid < 0) return;
    Args a{};
    for (int i = 0; i < 20; ++i) a.in[i] = (const float*)d_in[i];
    a.out = (float*)d_out; a.ws = (unsigned char*)d_ws;
    bf16_t* Wb = (bf16_t*)((unsigned char*)d_ws + WS_W);
    const float *mix_pre_g = a.in[2], *ffn_pre_g = a.in[4], *pool_w = a.in[6], *pool_scale = a.in[7], *kv_norm_g = a.in[8], *w_k = a.in[9], *w_v = a.in[10], *w_q = a.in[11], *w_o = a.in[12];
    const float *w_gate = a.in[14], *w_up = a.in[15], *w_down = a.in[16], *ple_norm_g = a.in[17], *w_pleg = a.in[18], *w_plep = a.in[19];
    int nj = 0;
    auto add = [&](const float* W, const float* gk, const float* gn, bf16_t* dst, int K, int N, int mode, float cs) { Job& J = a.jobs[nj++]; J.W = W; J.gk = gk; J.gn = gn; J.dst = dst; J.K = K; J.N = N; J.mode = mode; J.cs = cs; };
    for (int i = 0; i < 4; ++i) {
        add(w_gate + (size_t)i * D * FF, ffn_pre_g + i * D, nullptr, Wb + W_GU + i * W_GU_SZ, D, FF, 1, 1.f);
        add(w_up + (size_t)i * D * FF, ffn_pre_g + i * D, nullptr, Wb + W_GU + i * W_GU_SZ, D, FF, 2, 1.f);
        add(w_down + (size_t)i * FF * D, nullptr, nullptr, Wb + W_D + i * W_D_SZ, FF, D, 0, 1.f);
        add(w_pleg + (size_t)i * D * D, ple_norm_g + i * D, nullptr, Wb + W_PG + i * W_PG_SZ, D, D, 0, 1.f);
        add(w_plep + (size_t)i * PLE * D, nullptr, nullptr, Wb + W_PP + i * W_PP_SZ, PLE, D, 0, 1.f);
    }
    for (int i = 0; i < 2; ++i) for (int g = 0; g < 4; ++g)
        add(pool_w + ((size_t)i * 4 + g) * 256 * 256, nullptr, pool_scale + i * D + g * 256, Wb + W_POOL + i * W_POOL_SZ + (size_t)g * 256 * 256, 256, 256, 0, 1.f);
    add(w_q, mix_pre_g + 2 * D, nullptr, Wb + W_QKV, D, D, 3, C2);
    add(w_k, kv_norm_g, nullptr, Wb + W_QKV + (size_t)1024 * D, D, 256, 3, 1.f);
    add(w_v, kv_norm_g, nullptr, Wb + W_QKV + (size_t)1280 * D, D, 256, 0, 1.f);
    add(w_q + (size_t)D * D, mix_pre_g + 3 * D, nullptr, Wb + W_Q3, D, D, 3, C2);
    add(w_o, nullptr, nullptr, Wb + W_O, D, D, 0, 1.f);
    add(w_o + (size_t)D * D, nullptr, nullptr, Wb + W_O + (size_t)D * D, D, D, 0, 1.f);
    (void)hipMemsetAsync((unsigned char*)d_ws + WS_BAR, 0, BAR_ZERO_BYTES, stream);
    void* kargs[] = {&a};
    hipError_t e = hipLaunchCooperativeKernel((const void*)mk_fwd, dim3(grid), dim3(NTHREADS), kargs, LDS_BYTES, stream);
    if (e != hipSuccess) fprintf(stderr, "cooperative launch failed: %s (grid %d)\n", hipGetErrorString(e), grid);
}
```

```cpp
#include <hip/hip_runtime.h>
#include <hip/hip_cooperative_groups.h>
#include <cstdint>
#include <cstdio>
namespace cg = cooperative_groups;

#define LAS __attribute__((address_space(3)))
#define GAS __attribute__((address_space(1)))
typedef unsigned short bf16_t;
typedef short bf16x8 __attribute__((ext_vector_type(8)));
typedef short s16x4 __attribute__((ext_vector_type(4)));
typedef float f32x4 __attribute__((ext_vector_type(4)));
typedef float f32x2 __attribute__((ext_vector_type(2)));
typedef float f32x16 __attribute__((ext_vector_type(16)));
typedef unsigned u32x4 __attribute__((ext_vector_type(4)));
typedef unsigned u32x2 __attribute__((ext_vector_type(2)));

constexpr int T = 32768, SEQ = 16384, D = 1024, FF = 2816, PLE = 256;
constexpr float EPS = 1e-6f;
constexpr float LOG2E = 1.4426950408889634f;
constexpr float C2 = 0.125f * LOG2E;
constexpr int NWAVES = 8, NTHREADS = 512;

constexpr size_t MiB = 1u << 20;
constexpr size_t WS_W = 0;
constexpr size_t WS_HB = 88 * MiB;
constexpr size_t WS_MB = 152 * MiB;
constexpr size_t WS_ACT = 216 * MiB;
constexpr size_t WS_K = 392 * MiB, WS_V = 408 * MiB, WS_PB = 424 * MiB;
constexpr size_t WS_COS = 440 * MiB, WS_SIN = 442 * MiB, WS_PSSA = 444 * MiB, WS_PSSB = 446 * MiB, WS_PP = 448 * MiB, WS_END = 512 * MiB;
constexpr size_t WS_BAR = 86 * MiB;
constexpr size_t WS_XS = 87 * MiB;
constexpr size_t BAR_ZERO_BYTES = 65536;
constexpr size_t W_GU = 0, W_GU_SZ = (size_t)2 * FF * D;
constexpr size_t W_D = W_GU + 4 * W_GU_SZ, W_D_SZ = (size_t)D * FF;
constexpr size_t W_PG = W_D + 4 * W_D_SZ, W_PG_SZ = (size_t)D * D;
constexpr size_t W_PP = W_PG + 4 * W_PG_SZ, W_PP_SZ = (size_t)D * PLE;
constexpr size_t W_POOL = W_PP + 4 * W_PP_SZ, W_POOL_SZ = (size_t)D * 256;
constexpr size_t W_QKV = W_POOL + 2 * W_POOL_SZ, W_QKV_SZ = (size_t)1536 * D;
constexpr size_t W_Q3 = W_QKV + W_QKV_SZ;
constexpr size_t W_O = W_Q3 + (size_t)D * D;
constexpr size_t W_END = W_O + 2 * (size_t)D * D;
static_assert(W_END * 2 <= WS_BAR, "weights fit");

constexpr int LDS_BYTES = 147456;

typedef __bf16 bf16x2_t __attribute__((ext_vector_type(2)));
__device__ __forceinline__ unsigned cvt_pk_bf16(float lo, float hi) { const f32x2 v = {lo, hi}; const bf16x2_t b = __builtin_convertvector(v, bf16x2_t); return __builtin_bit_cast(unsigned, b); }
__device__ __forceinline__ float bf_lo(unsigned w) { return __uint_as_float(w << 16); }
__device__ __forceinline__ float bf_hi(unsigned w) { return __uint_as_float(w & 0xffff0000u); }
__device__ __forceinline__ float shx(float v, int mask, int lane) { return __int_as_float(__builtin_amdgcn_ds_bpermute((lane ^ mask) << 2, __float_as_int(v))); }
__device__ __forceinline__ float wave_sum(float v, int lane) {
#pragma unroll
    for (int o = 1; o < 64; o <<= 1) v += shx(v, o, lane);
    return v;
}
__device__ __forceinline__ float sigmoid_f(float v) { return __builtin_amdgcn_rcpf(1.0f + __expf(-v)); }

namespace pg8 {
constexpr int BM = 256, BK = 64, HALF = 128, HTB = HALF * BK * 2, STAGE_BYTES = 8 * HTB, NXCD = 8, WGM = 8;
__device__ __forceinline__ int lds_byte(int r, int c) { const int st = (r >> 4) * 2 + (c >> 5), rr = r & 15, cc = c & 31, ob = rr * 64 + cc * 2; return st * 1024 + (ob ^ (((ob >> 9) & 1) << 5)); }
__device__ __forceinline__ void stage_rc(int b, int& R, int& C) { const int st = b / 1024, sb = b % 1024, swz = sb ^ (((sb >> 9) & 1) << 5); R = (st >> 1) * 16 + swz / 64; C = (st & 1) * 32 + (swz % 64) / 2; }
__device__ __forceinline__ int perm32(int rho) { const int n = rho >> 4, i = rho & 15; return 8 * (i >> 2) + 4 * n + (i & 3); }

struct Unit { int pm, pn; };
struct Gemm { const bf16_t* A; const bf16_t* Bt; int lda, K, a_pn_off; };

struct StaticOrder {
    int nM, nN, nwg, G, c;
    __device__ void init(int M, int N, int G_, int c_) { nM = M / BM; nN = N / BM; nwg = nM * nN; G = G_; c = c_; }
    __device__ bool next(int i, Unit& u) const {
        const int L = i * G + c; if (L >= nwg) return false;
        int wgid = L; { const int q = nwg / NXCD, r = nwg % NXCD, xcd = wgid % NXCD, off = wgid / NXCD; wgid = (xcd < r ? xcd * (q + 1) : r * (q + 1) + (xcd - r) * q) + off; }
        const int nig = WGM * nN, gid = wgid / nig, fm = gid * WGM, gsz = (nM - fm) < WGM ? (nM - fm) : WGM;
        u.pm = fm + ((wgid % nig) % gsz); u.pn = (wgid % nig) / gsz; return true;
    }
};

typedef f32x4 Acc[2][2][4][2];

template <class Epi>
__device__ __forceinline__ void gemm_phase(LAS unsigned char* lds, const Gemm g, const StaticOrder& S, const Epi& E, const int tid) {
    const int wid = __builtin_amdgcn_readfirstlane(tid >> 6), lane = tid & 63, wr = wid >> 2, wc = wid & 3, fr = lane & 15, fq = lane >> 4;
    const int K = g.K, nt = K / BK, lda = g.lda;
    unsigned voffA[2], voffB[2];
#pragma unroll
    for (int i = 0; i < 2; ++i) { int R, C; stage_rc(tid * 16 + i * 8192, R, C); const int Rb = (R & ~31) + perm32(R & 31);
        voffA[i] = (unsigned)(R * lda + C) * 2u; voffB[i] = (unsigned)(Rb * K + C) * 2u; }
    const size_t kstep = (size_t)(BK * 2);
    const size_t hstepA = (size_t)HALF * lda * 2, hstepB = (size_t)HALF * K * 2;
    const unsigned ldsw = (unsigned)wid * 1024u;
    const int aoff = lds_byte(wr * 64 + fr, fq * 8), boff = lds_byte(wc * 32 + fr, fq * 8);
#define PG8_SA(b, h) (((b) * 2 + (h)) * HTB)
#define PG8_SB(b, h) ((4 + (b) * 2 + (h)) * HTB)
#define PG8_STAGE(bufoff, gbase, voff) do { _Pragma("unroll") for (int _i = 0; _i < 2; ++_i) \
        __builtin_amdgcn_global_load_lds((const unsigned*)((const char*)(gbase) + (voff)[_i]), (LAS unsigned*)(lds + (bufoff) + ldsw + _i * 8192), 16, 0, 0); } while (0)
#define PG8_LDA(dst, b, h) do { _Pragma("unroll") for (int m = 0; m < 4; ++m) _Pragma("unroll") for (int k = 0; k < 2; ++k) dst[m][k] = *(const LAS bf16x8*)(lds + PG8_SA(b, h) + aoff + m * 2048 + k * 1024); } while (0)
#define PG8_LDB(dst, b, h) do { _Pragma("unroll") for (int n = 0; n < 2; ++n) _Pragma("unroll") for (int k = 0; k < 2; ++k) dst[n][k] = *(const LAS bf16x8*)(lds + PG8_SB(b, h) + boff + n * 2048 + k * 1024); } while (0)
#define PG8_MMA(ai, bj, At, Bt) do { __builtin_amdgcn_s_setprio(1); _Pragma("unroll") for (int m = 0; m < 4; ++m) _Pragma("unroll") for (int n = 0; n < 2; ++n) _Pragma("unroll") for (int k = 0; k < 2; ++k) \
        acc[ai][bj][m][n] = __builtin_amdgcn_mfma_f32_16x16x32_bf16(Bt[n][k], At[m][k], acc[ai][bj][m][n], 0, 0, 0); __builtin_amdgcn_s_setprio(0); } while (0)
#define PG8_WAIT_V(n) asm volatile("s_waitcnt vmcnt(" #n ")" ::: "memory")
#define PG8_WAIT_L(n) asm volatile("s_waitcnt lgkmcnt(" #n ")" ::: "memory")
#define PG8_BAR __builtin_amdgcn_s_barrier()
#define PG8_SCHED __builtin_amdgcn_sched_barrier(0)
    if (tid == 0) *(LAS int*)(lds + 131072 + 7168) = -1;
    Unit cur, nxt; int ui = 0;
    if (!S.next(0, cur)) return;
    f32x4 acc[2][2][4][2];
#pragma unroll
    for (int a = 0; a < 2; ++a)
#pragma unroll
        for (int b = 0; b < 2; ++b)
#pragma unroll
            for (int m = 0; m < 4; ++m)
#pragma unroll
                for (int n = 0; n < 2; ++n) acc[a][b][m][n] = (f32x4){0.f, 0.f, 0.f, 0.f};
    bf16x8 At[4][2], B0[2][2], B1[2][2];
    const char* cA = (const char*)g.A + ((size_t)cur.pm * BM * lda + (size_t)cur.pn * g.a_pn_off) * 2; const char* cB = (const char*)g.Bt + (size_t)cur.pn * 2 * hstepB;
    PG8_STAGE(PG8_SB(0, 0), cB, voffB); PG8_STAGE(PG8_SB(0, 1), cB + hstepB, voffB); PG8_STAGE(PG8_SA(0, 0), cA, voffA); PG8_STAGE(PG8_SA(0, 1), cA + hstepA, voffA);
    if (wr == 1) PG8_BAR;
    PG8_WAIT_V(2); PG8_BAR;
    PG8_STAGE(PG8_SB(1, 0), cB + kstep, voffB); PG8_STAGE(PG8_SA(1, 0), cA + kstep, voffA); PG8_STAGE(PG8_SB(1, 1), cB + hstepB + kstep, voffB);
    PG8_WAIT_V(6); PG8_BAR;
    for (;;) {
        const bool has_next = S.next(ui + 1, nxt);
        const char* nA = has_next ? (const char*)g.A + ((size_t)nxt.pm * BM * lda + (size_t)nxt.pn * g.a_pn_off) * 2 : cA; const char* nB = has_next ? (const char*)g.Bt + (size_t)nxt.pn * 2 * hstepB : cB;
        for (int t = 0; t < nt; t += 2) {
            const bool last = (t == nt - 2);
            const char* a1 = cA + (size_t)(t + 1) * kstep;
            const char* a2 = last ? nA : cA + (size_t)(t + 2) * kstep; const char* b2 = last ? nB : cB + (size_t)(t + 2) * kstep;
            const char* a3 = a2 + kstep; const char* b3 = b2 + kstep;
            PG8_LDB(B0, 0, 0); PG8_LDB(B1, 0, 1); PG8_SCHED; PG8_LDA(At, 0, 0); PG8_STAGE(PG8_SA(1, 1), a1 + hstepA, voffA);
            PG8_WAIT_V(8); PG8_WAIT_L(0); PG8_BAR; PG8_MMA(0, 0, At, B0); PG8_MMA(0, 1, At, B1); PG8_BAR; PG8_SCHED;
            PG8_LDA(At, 0, 1); PG8_STAGE(PG8_SB(0, 0), b2, voffB); PG8_STAGE(PG8_SB(0, 1), b2 + hstepB, voffB); PG8_STAGE(PG8_SA(0, 0), a2, voffA);
            PG8_WAIT_V(8); PG8_WAIT_L(0); PG8_BAR; PG8_MMA(1, 0, At, B0); PG8_MMA(1, 1, At, B1); PG8_BAR; PG8_SCHED;
            PG8_LDB(B0, 1, 0); PG8_LDB(B1, 1, 1); PG8_SCHED; PG8_LDA(At, 1, 0); PG8_STAGE(PG8_SA(0, 1), a2 + hstepA, voffA);
            PG8_WAIT_V(8); PG8_WAIT_L(0); PG8_BAR; PG8_MMA(0, 0, At, B0); PG8_MMA(0, 1, At, B1); PG8_BAR; PG8_SCHED;
            PG8_LDA(At, 1, 1); PG8_STAGE(PG8_SB(1, 0), b3, voffB); PG8_STAGE(PG8_SB(1, 1), b3 + hstepB, voffB); PG8_STAGE(PG8_SA(1, 0), a3, voffA);
            PG8_WAIT_V(8); PG8_WAIT_L(0); PG8_BAR; PG8_MMA(1, 0, At, B0); PG8_MMA(1, 1, At, B1); PG8_BAR; PG8_SCHED;
        }
        if (wr == 0) PG8_BAR;
        { int tl = tid; asm volatile("" : "+v"(tl)); E(acc, cur, wr, wc, fr, fq, lds + 131072, wid, tl & 63); }
        if (!has_next) break;
#pragma unroll
        for (int a = 0; a < 2; ++a)
#pragma unroll
            for (int b = 0; b < 2; ++b)
#pragma unroll
                for (int m = 0; m < 4; ++m)
#pragma unroll
                    for (int n = 0; n < 2; ++n) acc[a][b][m][n] = (f32x4){0.f, 0.f, 0.f, 0.f};
        cur = nxt; cA = nA; cB = nB; ++ui;
        if (wr == 1) PG8_BAR;
    }
    PG8_WAIT_V(0);
    PG8_BAR;
#undef PG8_SA
#undef PG8_SB
#undef PG8_STAGE
#undef PG8_LDA
#undef PG8_LDB
#undef PG8_MMA
#undef PG8_WAIT_V
#undef PG8_WAIT_L
#undef PG8_BAR
#undef PG8_SCHED
}

__device__ __forceinline__ u32x4 pack8(f32x4 v0, f32x4 v1) { u32x4 w; w.x = cvt_pk_bf16(v0[0], v0[1]); w.y = cvt_pk_bf16(v0[2], v0[3]); w.z = cvt_pk_bf16(v1[0], v1[1]); w.w = cvt_pk_bf16(v1[2], v1[3]); return w; }

__device__ __forceinline__ float rstd_from_pss(const float* pss, int row) {
    const GAS f32x4* p = (const GAS f32x4*)(pss + (size_t)row * 4); const f32x4 a = p[0], b = p[T], c = p[2 * T], d = p[3 * T];
    const float s = ((a[0] + a[1]) + (a[2] + a[3])) + ((b[0] + b[1]) + (b[2] + b[3])) + ((c[0] + c[1]) + (c[2] + c[3])) + ((d[0] + d[1]) + (d[2] + d[3]));
    return rsqrtf(s * (1.0f / D) + EPS);
}
__device__ __forceinline__ const LAS float* panel_rstd(const float* pss, int pm, LAS unsigned char* xl, int wid, int lane) {
    LAS float* S = (LAS float*)(xl + 6144); LAS int* tag = (LAS int*)(xl + 7168);
    const int t = __builtin_amdgcn_readfirstlane(*tag);
    if (t != pm) {
        asm volatile("s_waitcnt lgkmcnt(0)" ::: "memory"); __builtin_amdgcn_s_barrier(); asm volatile("" ::: "memory");
        const int tid = wid * 64 + lane;
        if (tid < 256) S[tid] = rstd_from_pss(pss, pm * BM + tid);
        if (tid == 0) *tag = pm;
        asm volatile("s_waitcnt lgkmcnt(0)" ::: "memory"); __builtin_amdgcn_s_barrier(); asm volatile("" ::: "memory");
    }
    return S;
}
struct EpiPlain {
    bf16_t* O; int ldc; const float* rs;
    __device__ __forceinline__ void operator()(const Acc& acc, const Unit& u, int wr, int wc, int fr, int fq, LAS unsigned char* xl, int wid, int lane) const {
        asm volatile("" : "+v"(lane)); fr = lane & 15; fq = lane >> 4;
        const int row0 = u.pm * BM + wr * 64 + fr, col0 = u.pn * BM + wc * 32 + 8 * fq;
#pragma unroll
        for (int ai = 0; ai < 2; ++ai)
#pragma unroll
            for (int m = 0; m < 4; ++m) { const int row = row0 + ai * HALF + m * 16; const float sc = rs ? rs[row] : 1.0f; bf16_t* rowp = O + (size_t)row * ldc + col0;
#pragma unroll
                for (int bj = 0; bj < 2; ++bj) *(GAS u32x4*)(rowp + bj * HALF) = pack8(acc[ai][bj][m][0] * sc, acc[ai][bj][m][1] * sc); }
    }
};
struct EpiSwiglu {
    bf16_t* O; const float* pss;
    __device__ __forceinline__ void operator()(const Acc& acc, const Unit& u, int wr, int wc, int fr, int fq, LAS unsigned char* xl, int wid, int lane) const {
        asm volatile("" : "+v"(lane)); fr = lane & 15; fq = lane >> 4;
        const int row0 = u.pm * BM + wr * 64 + fr, col0 = u.pn * HALF + wc * 32 + 8 * fq;
        const LAS float* RS_ = panel_rstd(pss, u.pm, xl, wid, lane);
#pragma unroll
        for (int ai = 0; ai < 2; ++ai)
#pragma unroll
            for (int m = 0; m < 4; ++m) { const int row = row0 + ai * HALF + m * 16; const float sc = RS_[ai * HALF + wr * 64 + m * 16 + fr];
                f32x4 o[2];
#pragma unroll
                for (int n = 0; n < 2; ++n)
#pragma unroll
                    for (int i = 0; i < 4; ++i) { const float gv = acc[ai][0][m][n][i] * sc, uv = acc[ai][1][m][n][i] * sc; o[n][i] = gv * sigmoid_f(gv) * uv; }
                *(GAS u32x4*)(O + (size_t)row * FF + col0) = pack8(o[0], o[1]); }
    }
};
struct EpiQKV {
    bf16_t *Q, *Kb, *Vb; const float *cosT, *sinT; const float* pss;
    __device__ __forceinline__ void operator()(const Acc& acc, const Unit& u, int wr, int wc, int fr, int fq, LAS unsigned char* xl, int wid, int lane) const {
        asm volatile("" : "+v"(lane)); fr = lane & 15; fq = lane >> 4;
        const int row0 = u.pm * BM + wr * 64 + fr;
        const LAS float* RS_ = panel_rstd(pss, u.pm, xl, wid, lane);
        if (u.pn < 5) {
            bf16_t* base; int ldc, colh;
            if (u.pn < 4) { base = Q; ldc = D; colh = (4 * u.pn + wc) * 64 + 8 * fq; } else { base = Kb; ldc = 256; colh = wc * 64 + 8 * fq; }
#pragma unroll
            for (int ai = 0; ai < 2; ++ai)
#pragma unroll
                for (int m = 0; m < 4; ++m) { const int row = row0 + ai * HALF + m * 16; const float sc = RS_[ai * HALF + wr * 64 + m * 16 + fr]; const int pos = row & (SEQ - 1);
                    const f32x4 c0 = *(const GAS f32x4*)(cosT + pos * 32 + 8 * fq), c1 = *(const GAS f32x4*)(cosT + pos * 32 + 8 * fq + 4);
                    const f32x4 s0 = *(const GAS f32x4*)(sinT + pos * 32 + 8 * fq), s1 = *(const GAS f32x4*)(sinT + pos * 32 + 8 * fq + 4);
                    const f32x4 a0 = acc[ai][0][m][0] * sc, a1 = acc[ai][0][m][1] * sc, b0 = acc[ai][1][m][0] * sc, b1 = acc[ai][1][m][1] * sc;
                    bf16_t* rowp = base + (size_t)row * ldc + colh;
                    *(GAS u32x4*)(rowp) = pack8(a0 * c0 - b0 * s0, a1 * c1 - b1 * s1);
                    *(GAS u32x4*)(rowp + 32) = pack8(b0 * c0 + a0 * s0, b1 * c1 + a1 * s1); }
        } else {
            const int col0 = wc * 32 + 8 * fq;
#pragma unroll
            for (int ai = 0; ai < 2; ++ai)
#pragma unroll
                for (int m = 0; m < 4; ++m) { const int row = row0 + ai * HALF + m * 16; const float sc = RS_[ai * HALF + wr * 64 + m * 16 + fr]; bf16_t* rowp = Vb + (size_t)row * 256 + col0;
#pragma unroll
                    for (int bj = 0; bj < 2; ++bj) *(GAS u32x4*)(rowp + bj * HALF) = pack8(acc[ai][bj][m][0] * sc, acc[ai][bj][m][1] * sc); }
        }
    }
};
template <bool SRC_F32> struct EpiNorm {
    const void* hsrc; bf16_t* HB; const float* g; float* pss; unsigned long long* xs; unsigned tag;
    __device__ __forceinline__ void operator()(const Acc& acc, const Unit& u, int wr, int wc, int fr, int fq, LAS unsigned char* xl, int wid, int lane) const {
        asm volatile("" : "+v"(lane)); fr = lane & 15; fq = lane >> 4;
        LAS float* P = (LAS float*)xl; LAS float* S = (LAS float*)(xl + 4096);
        const int col0 = u.pn * BM + wc * 32 + 8 * fq;
        u32x4 hpre[2][4][2];
        if (!SRC_F32) {
#pragma unroll
            for (int ai = 0; ai < 2; ++ai)
#pragma unroll
                for (int m = 0; m < 4; ++m)
#pragma unroll
                    for (int bj = 0; bj < 2; ++bj) hpre[ai][m][bj] = *(const GAS u32x4*)((const bf16_t*)hsrc + (size_t)(u.pm * BM + ai * HALF + wr * 64 + m * 16 + fr) * D + col0 + bj * HALF);
        }
#pragma unroll
        for (int ai = 0; ai < 2; ++ai)
#pragma unroll
            for (int m = 0; m < 4; ++m) { float ss = 0.f;
#pragma unroll
                for (int bj = 0; bj < 2; ++bj)
#pragma unroll
                    for (int n = 0; n < 2; ++n) { const f32x4 v = acc[ai][bj][m][n]; ss += (v[0] * v[0] + v[1] * v[1]) + (v[2] * v[2] + v[3] * v[3]); }
                ss += shx(ss, 16, lane); ss += shx(ss, 32, lane);
                if (fq == 0) P[(ai * HALF + wr * 64 + m * 16 + fr) * 4 + wc] = ss; }
        asm volatile("s_waitcnt lgkmcnt(0)" ::: "memory"); __builtin_amdgcn_s_barrier(); asm volatile("" ::: "memory");
        const int rl = wid * 32 + (lane & 31);
        if (lane < 32) {
            const f32x4 t4 = *(const LAS f32x4*)(P + rl * 4); const float s = (t4[0] + t4[1]) + (t4[2] + t4[3]);
            float v0 = s, v1 = s, v2 = s, v3 = s;
            unsigned long long* sl = xs + (size_t)(u.pm * BM + rl) * 4;
            __hip_atomic_store(sl + u.pn, ((unsigned long long)tag << 32) | (unsigned long long)__float_as_uint(s), __ATOMIC_RELAXED, __HIP_MEMORY_SCOPE_AGENT);
            unsigned done = 1u << u.pn, sp = 0;
            for (;;) {
#pragma unroll
                for (int t = 0; t < 4; ++t) if (!(done & (1u << t))) { const unsigned long long w = __hip_atomic_load(sl + t, __ATOMIC_RELAXED, __HIP_MEMORY_SCOPE_AGENT);
                    if ((unsigned)(w >> 32) == tag) { const float pv = __uint_as_float((unsigned)w); if (t == 0) v0 = pv; else if (t == 1) v1 = pv; else if (t == 2) v2 = pv; else v3 = pv; done |= 1u << t; } }
                if (__builtin_amdgcn_ballot_w64(done != 15u) == 0ull) break;
                if (++sp > (1u << 22)) break;
                __builtin_amdgcn_s_sleep(1);
            }
            S[rl] = rsqrtf(((v0 + v1) + (v2 + v3)) * (1.0f / D) + EPS);
        }
        asm volatile("s_waitcnt vmcnt(0) lgkmcnt(0)" ::: "memory"); __builtin_amdgcn_s_barrier(); asm volatile("" ::: "memory");
        f32x4 gv[2][2];
#pragma unroll
        for (int bj = 0; bj < 2; ++bj)
#pragma unroll
            for (int n = 0; n < 2; ++n) gv[bj][n] = *(const GAS f32x4*)(g + col0 + bj * HALF + 4 * n);
#pragma unroll
        for (int ai = 0; ai < 2; ++ai)
#pragma unroll
            for (int m = 0; m < 4; ++m) { const int rloc = ai * HALF + wr * 64 + m * 16 + fr; const float sr = S[rloc]; const int row = u.pm * BM + rloc; const size_t off = (size_t)row * D + col0; float ss = 0.f;
#pragma unroll
                for (int bj = 0; bj < 2; ++bj) {
                    f32x4 h0, h1;
                    if (SRC_F32) { h0 = *(const GAS f32x4*)((const float*)hsrc + off + bj * HALF); h1 = *(const GAS f32x4*)((const float*)hsrc + off + bj * HALF + 4); }
                    else { const u32x4 hw = hpre[ai][m][bj]; h0[0] = bf_lo(hw.x); h0[1] = bf_hi(hw.x); h0[2] = bf_lo(hw.y); h0[3] = bf_hi(hw.y); h1[0] = bf_lo(hw.z); h1[1] = bf_hi(hw.z); h1[2] = bf_lo(hw.w); h1[3] = bf_hi(hw.w); }
                    const f32x4 o0 = h0 + acc[ai][bj][m][0] * sr * gv[bj][0], o1 = h1 + acc[ai][bj][m][1] * sr * gv[bj][1];
                    ss += ((o0[0] * o0[0] + o0[1] * o0[1]) + (o0[2] * o0[2] + o0[3] * o0[3])) + ((o1[0] * o1[0] + o1[1] * o1[1]) + (o1[2] * o1[2] + o1[3] * o1[3]));
                    *(GAS u32x4*)(HB + off + bj * HALF) = pack8(o0, o1); }
                ss += shx(ss, 16, lane); ss += shx(ss, 32, lane);
                if (fq == 0) ((GAS float*)pss)[((size_t)u.pn * T + row) * 4 + wc] = ss;
                if (m & 1) asm volatile("" ::: "memory"); }
    }
};
template <bool LAST> struct EpiPle {
    const bf16_t* HX; bf16_t* HY; float* OUT; const bf16_t* PP; const float* pssa; float* pss;
    __device__ __forceinline__ void operator()(const Acc& acc, const Unit& u, int wr, int wc, int fr, int fq, LAS unsigned char* xl, int wid, int lane) const {
        asm volatile("" : "+v"(lane)); fr = lane & 15; fq = lane >> 4;
        const int row0 = u.pm * BM + wr * 64 + fr, col0 = u.pn * BM + wc * 32 + 8 * fq;
        const LAS float* RS_ = panel_rstd(pssa, u.pm, xl, wid, lane);
#pragma unroll
        for (int ai = 0; ai < 2; ++ai) {
            u32x4 hq[4][2], pq[4][2]; float scq[4];
#pragma unroll
            for (int m = 0; m < 4; ++m) { scq[m] = RS_[ai * HALF + wr * 64 + m * 16 + fr];
#pragma unroll
                for (int bj = 0; bj < 2; ++bj) { const size_t off = (size_t)(row0 + ai * HALF + m * 16) * D + col0 + bj * HALF; hq[m][bj] = *(const GAS u32x4*)(HX + off); pq[m][bj] = *(const GAS u32x4*)(PP + off); } }
            asm volatile("s_waitcnt vmcnt(0) lgkmcnt(0)" : "+v"(hq[0][0]), "+v"(hq[3][1]), "+v"(pq[0][0]), "+v"(pq[3][1]) :: "memory");
#pragma unroll
            for (int m = 0; m < 4; ++m) { const int row = row0 + ai * HALF + m * 16; const float sc = scq[m]; const size_t off = (size_t)row * D + col0; float ss = 0.f;
#pragma unroll
                for (int bj = 0; bj < 2; ++bj) {
                    const u32x4 hw = hq[m][bj]; const u32x4 pw = pq[m][bj];
                    f32x4 h0, h1, p0, p1;
                    h0[0] = bf_lo(hw.x); h0[1] = bf_hi(hw.x); h0[2] = bf_lo(hw.y); h0[3] = bf_hi(hw.y); h1[0] = bf_lo(hw.z); h1[1] = bf_hi(hw.z); h1[2] = bf_lo(hw.w); h1[3] = bf_hi(hw.w);
                    p0[0] = bf_lo(pw.x); p0[1] = bf_hi(pw.x); p0[2] = bf_lo(pw.y); p0[3] = bf_hi(pw.y); p1[0] = bf_lo(pw.z); p1[1] = bf_hi(pw.z); p1[2] = bf_lo(pw.w); p1[3] = bf_hi(pw.w);
                    f32x4 o0, o1;
#pragma unroll
                    for (int i = 0; i < 4; ++i) { o0[i] = h0[i] + p0[i] * sigmoid_f(acc[ai][bj][m][0][i] * sc); o1[i] = h1[i] + p1[i] * sigmoid_f(acc[ai][bj][m][1][i] * sc); ss += o0[i] * o0[i] + o1[i] * o1[i]; }
                    if (LAST) { *(GAS f32x4*)(OUT + off + bj * HALF) = o0; *(GAS f32x4*)(OUT + off + bj * HALF + 4) = o1; }
                    else *(GAS u32x4*)(HY + off + bj * HALF) = pack8(o0, o1); }
                if (!LAST) { ss += shx(ss, 16, lane); ss += shx(ss, 32, lane);
                    if (fq == 0) ((GAS float*)pss)[((size_t)u.pn * T + row) * 4 + wc] = ss; } }
            asm volatile("" ::: "memory"); }
    }
};
}

struct Job { const float* W; const float* gk; const float* gn; bf16_t* dst; int K, N, mode; float cs; };
constexpr int NJOBS = 34;
struct Args { const float* in[20]; float* out; unsigned char* ws; Job jobs[NJOBS]; };

__device__ __forceinline__ int dest_row(int mode, int n) {
    if (mode == 0) return n;
    if (mode == 1) return (n >> 7) * 256 + (n & 127);
    if (mode == 2) return (n >> 7) * 256 + 128 + (n & 127);
    const int head = n >> 6, d = n & 63; return (head >> 2) * 256 + (d >> 5) * 128 + (head & 3) * 32 + (d & 31);
}
__device__ __forceinline__ void wconv_item(const float* W, const float* gk, const float* gn, bf16_t* dst, int K, int N, int mode, float cs, LAS float* scr, int item, int lane) {
    const int nblk = N / 32, kb = item / nblk, nb = item % nblk, k0 = 64 * kb, n0 = 32 * nb;
    float wv[32];
#pragma unroll
    for (int i = 0; i < 32; ++i) wv[i] = ((const GAS float*)W)[(size_t)(k0 + 2 * i + (lane >> 5)) * N + n0 + (lane & 31)];
    if (gk) {
#pragma unroll
        for (int i = 0; i < 32; ++i) wv[i] *= ((const GAS float*)gk)[k0 + 2 * i + (lane >> 5)]; }
#pragma unroll
    for (int i = 0; i < 32; ++i) scr[(2 * i + (lane >> 5)) * 33 + (lane & 31)] = wv[i];
    asm volatile("s_waitcnt lgkmcnt(0)" ::: "memory");
    const int c = lane & 7;
#pragma unroll
    for (int j = 0; j < 4; ++j) { const int n = (lane >> 3) + 8 * j; const LAS float* s = scr + (8 * c) * 33 + n; const float sc = gn ? cs * ((const GAS float*)gn)[n0 + n] : cs;
        u32x4 o; o.x = cvt_pk_bf16(s[0 * 33] * sc, s[1 * 33] * sc); o.y = cvt_pk_bf16(s[2 * 33] * sc, s[3 * 33] * sc); o.z = cvt_pk_bf16(s[4 * 33] * sc, s[5 * 33] * sc); o.w = cvt_pk_bf16(s[6 * 33] * sc, s[7 * 33] * sc);
        *(GAS u32x4*)(dst + (size_t)dest_row(mode, n0 + n) * K + k0 + 8 * c) = o; }
    asm volatile("s_waitcnt lgkmcnt(0)" ::: "memory");
}
__device__ __forceinline__ void wconv_load(const float* W, const float* gk, int N, int item, int lane, float (&wv)[32], float (&gv)[32]) {
    const int nblk = N / 32, kb = item / nblk, nb = item % nblk, k0 = 64 * kb, n0 = 32 * nb;
#pragma unroll
    for (int i = 0; i < 32; ++i) wv[i] = ((const GAS float*)W)[(size_t)(k0 + 2 * i + (lane >> 5)) * N + n0 + (lane & 31)];
#pragma unroll
    for (int i = 0; i < 32; ++i) gv[i] = gk ? ((const GAS float*)gk)[k0 + 2 * i + (lane >> 5)] : 1.0f;
}
__device__ __forceinline__ void wconv_finish(const float* gn, bf16_t* dst, int K, int N, int mode, float cs, LAS float* scr, int item, int lane, const float (&wv)[32], const float (&gv)[32]) {
    const int nblk = N / 32, kb = item / nblk, nb = item % nblk, k0 = 64 * kb, n0 = 32 * nb;
#pragma unroll
    for (int i = 0; i < 32; ++i) scr[(2 * i + (lane >> 5)) * 33 + (lane & 31)] = wv[i] * gv[i];
    asm volatile("s_waitcnt lgkmcnt(0)" ::: "memory");
    const int c = lane & 7;
#pragma unroll
    for (int j = 0; j < 4; ++j) { const int n = (lane >> 3) + 8 * j; const LAS float* s = scr + (8 * c) * 33 + n; const float sc = gn ? cs * ((const GAS float*)gn)[n0 + n] : cs;
        u32x4 o; o.x = cvt_pk_bf16(s[0 * 33] * sc, s[1 * 33] * sc); o.y = cvt_pk_bf16(s[2 * 33] * sc, s[3 * 33] * sc); o.z = cvt_pk_bf16(s[4 * 33] * sc, s[5 * 33] * sc); o.w = cvt_pk_bf16(s[6 * 33] * sc, s[7 * 33] * sc);
        *(GAS u32x4*)(dst + (size_t)dest_row(mode, n0 + n) * K + k0 + 8 * c) = o; }
    asm volatile("s_waitcnt lgkmcnt(0)" ::: "memory");
}
__device__ __forceinline__ void conv_p(const float* p, bf16_t* pb, int gtid, int nthr) {
    constexpr int NV = T * PLE / 8;
    for (int i = gtid; i < NV; i += 2 * nthr) { const int i2 = (i + nthr < NV) ? i + nthr : i;
        const f32x4 a = *(const GAS f32x4*)(p + (size_t)i * 8), b = *(const GAS f32x4*)(p + (size_t)i * 8 + 4), c = *(const GAS f32x4*)(p + (size_t)i2 * 8), d = *(const GAS f32x4*)(p + (size_t)i2 * 8 + 4);
        *(GAS u32x4*)(pb + (size_t)i * 8) = pg8::pack8(a, b); *(GAS u32x4*)(pb + (size_t)i2 * 8) = pg8::pack8(c, d); }
}

template <int W, bool SRC_F32>
__device__ __forceinline__ void pool_cols(const void* h, float gx, float gy, bf16_t* pooled, const LAS float* rsl, int first, int t0, int s0, int c) {
    f32x2 ring[16];
#pragma unroll
    for (int i = 0; i < 16; ++i) ring[i] = (f32x2){0.f, 0.f};
    float Sx = 0.f, Sy = 0.f;
#define POOL_LD(dst, tb_) do { _Pragma("unroll") for (int i = 0; i < 16; ++i) { if (SRC_F32) dst[i] = *(const GAS f32x2*)((const float*)h + (size_t)((tb_) + i) * D + c); \
            else { const unsigned w_ = *(const GAS unsigned*)((const bf16_t*)h + (size_t)((tb_) + i) * D + c); dst[i] = (f32x2){bf_lo(w_), bf_hi(w_)}; } } } while (0)
    f32x2 v[16], vn[16];
    POOL_LD(v, first);
    for (int tb = first; tb < t0 + 128; tb += 16) {
        const int tbn = (tb + 16 < t0 + 128) ? tb + 16 : tb;
        POOL_LD(vn, tbn);
        const bool emit = tb >= t0;
#pragma unroll
        for (int i = 0; i < 16; ++i) {
            const float r = rsl[tb + i - first]; const float hx = v[i].x * r * gx, hy = v[i].y * r * gy;
            Sx += hx - ring[(i - W) & 15].x; Sy += hy - ring[(i - W) & 15].y; ring[i] = (f32x2){hx, hy};
            if (emit) { const int s = s0 + (tb + i - t0); const int cnt = (s + 1 < W) ? s + 1 : W; const float inv = 1.0f / (float)cnt;
                *(GAS unsigned*)(pooled + (size_t)(tb + i) * D + c) = cvt_pk_bf16(Sx * inv - hx, Sy * inv - hy); }
        }
#pragma unroll
        for (int i = 0; i < 16; ++i) v[i] = vn[i];
    }
#undef POOL_LD
}
template <bool SRC_F32>
__device__ __forceinline__ void pool_prep(const void* h, const float* gpre, bf16_t* pooled, LAS unsigned char* lds, int tid, int wave, int lane, const float* pss = nullptr) {
    LAS float* rsl = (LAS float*)lds;
    for (int run = blockIdx.x; run < T / 128; run += gridDim.x) {
        const int t0 = run * 128, s0 = t0 & (SEQ - 1), first = (s0 == 0) ? t0 : t0 - 16, nrows = t0 + 128 - first;
        if (!SRC_F32) { for (int r = tid; r < nrows; r += NTHREADS) rsl[r] = pg8::rstd_from_pss(pss, first + r); }
        else
        for (int rb = wave; rb < nrows; rb += 4 * NWAVES) {
            float ss[4];
            if (SRC_F32) { f32x4 v[4][4];
#pragma unroll
                for (int q = 0; q < 4; ++q) { const int r = (rb + NWAVES * q < nrows) ? rb + NWAVES * q : nrows - 1; const GAS f32x4* xr = (const GAS f32x4*)((const float*)h + (size_t)(first + r) * D) + lane;
#pragma unroll
                    for (int j = 0; j < 4; ++j) v[q][j] = xr[64 * j]; }
#pragma unroll
                for (int q = 0; q < 4; ++q) { float s = 0.f;
#pragma unroll
                    for (int j = 0; j < 4; ++j) s += (v[q][j][0] * v[q][j][0] + v[q][j][1] * v[q][j][1]) + (v[q][j][2] * v[q][j][2] + v[q][j][3] * v[q][j][3]);
                    ss[q] = s; } }
            else { ss[0] = ss[1] = ss[2] = ss[3] = 0.f; }
#pragma unroll
            for (int q = 0; q < 4; ++q) { const float s = wave_sum(ss[q], lane); const int r = rb + NWAVES * q; if (lane == 0 && r < nrows) rsl[r] = rsqrtf(s * (1.0f / D) + EPS); } }
        __syncthreads();
        const int c = 2 * tid, grp = tid >> 7; const float gx = ((const GAS float*)gpre)[c], gy = ((const GAS float*)gpre)[c + 1];
        if (grp == 0) pool_cols<2, SRC_F32>(h, gx, gy, pooled, rsl, first, t0, s0, c);
        else if (grp == 1) pool_cols<4, SRC_F32>(h, gx, gy, pooled, rsl, first, t0, s0, c);
        else if (grp == 2) pool_cols<8, SRC_F32>(h, gx, gy, pooled, rsl, first, t0, s0, c);
        else pool_cols<16, SRC_F32>(h, gx, gy, pooled, rsl, first, t0, s0, c);
        __syncthreads();
    }
}

__device__ __forceinline__ int crow(int r, int hi) { return (r & 3) + 8 * (r >> 2) + 4 * hi; }
constexpr int A_KOFF = 0, A_VOFF = 32768;
__device__ __forceinline__ void attn_load_kv(int u, const bf16_t* Kb, const bf16_t* Vb, u32x4 (&kw)[4], u32x4 (&vw)[4], int tid) {
    const int n = u & 127, bk = u >> 7, b = bk >> 2, kvh = bk & 3; const long kt0 = (long)b * SEQ + (long)n * 128 - 128;
#pragma unroll
    for (int i = 0; i < 4; ++i) { const int cidx = tid + 512 * i, kv = cidx >> 3, ch = cidx & 7;
        const bool ok = (n > 0 || kv >= 128); const unsigned msk = ok ? 0xffffffffu : 0u; const int kvs = ok ? kv : kv + 128;
        kw[i] = *(const GAS u32x4*)(Kb + (size_t)(kt0 + kvs) * 256 + kvh * 64 + ch * 8) & msk; vw[i] = *(const GAS u32x4*)(Vb + (size_t)(kt0 + kvs) * 256 + kvh * 64 + ch * 8) & msk; }
}
__device__ __forceinline__ void attn_phase(const bf16_t* Q, const bf16_t* Kb, const bf16_t* Vb, bf16_t* O, const float* sinks, LAS unsigned char* lds, int G, int tid, int wave, int lane) {
    const int r32 = lane & 31, hi = lane >> 5;
    int u = blockIdx.x; if (u >= 1024) return;
    u32x4 kw[4], vw[4]; attn_load_kv(u, Kb, Vb, kw, vw, tid);
    const float NEG = -__builtin_inff();
    for (; u < 1024; u += G) {
        const int n = u & 127, bk = u >> 7, b = bk >> 2, kvh = bk & 3; const long tok0 = (long)b * SEQ + (long)n * 128;
        const int head = kvh * 4 + (wave >> 1);
#pragma unroll
        for (int i = 0; i < 4; ++i) { const int cidx = tid + 512 * i, kv = cidx >> 3, ch = cidx & 7;
            *(LAS u32x4*)(lds + A_KOFF + kv * 128 + ((ch ^ ((kv >> 1) & 7)) << 4)) = kw[i];
            *(LAS u32x4*)(lds + A_VOFF + (ch >> 2) * 16384 + kv * 64 + (ch & 3) * 16) = vw[i]; }
        __syncthreads();
        if (u + G < 1024) attn_load_kv(u + G, Kb, Vb, kw, vw, tid);
        const float sink2 = ((const GAS float*)sinks)[head] * LOG2E;
#pragma unroll
        for (int it = 0; it < 2; ++it) {
            const int r0 = ((wave & 1) * 2 + it) * 32, jt0 = r0 >> 5;
            bf16x8 qf[4]; { const bf16_t* qp = Q + (size_t)(tok0 + r0 + r32) * D + head * 64 + hi * 8;
#pragma unroll
                for (int d0 = 0; d0 < 4; ++d0) qf[d0] = *(const GAS bf16x8*)(qp + d0 * 16); }
            f32x16 p[5];
            bf16x8 kf[2][4];
#define ATT_LDK(buf, j_) do { const int kvrow_ = (jt0 + (j_)) * 32 + r32; _Pragma("unroll") for (int d0 = 0; d0 < 4; ++d0) { const int ch_ = 2 * d0 + hi; \
                kf[buf][d0] = *(const LAS bf16x8*)(lds + A_KOFF + kvrow_ * 128 + ((ch_ ^ ((kvrow_ >> 1) & 7)) << 4)); } } while (0)
            ATT_LDK(0, 0);
#pragma unroll
            for (int j = 0; j < 5; ++j) {
                if (j < 4) ATT_LDK((j + 1) & 1, j + 1);
                const f32x16 zero16 = {0.f, 0.f, 0.f, 0.f, 0.f, 0.f, 0.f, 0.f, 0.f, 0.f, 0.f, 0.f, 0.f, 0.f, 0.f, 0.f};
                f32x16 c0 = zero16;
                if (j == 0 || j == 4) { int rl_ = r32; asm volatile("" : "+v"(rl_));
#pragma unroll
                    for (int r = 0; r < 16; ++r) c0[r] = ((j == 0) ? (crow(r, hi) <= rl_) : (crow(r, hi) > rl_)) ? NEG : 0.f; }
                p[j] = __builtin_amdgcn_mfma_f32_32x32x16_bf16(kf[j & 1][0], qf[0], c0, 0, 0, 0);
#pragma unroll
                for (int d0 = 1; d0 < 4; ++d0) p[j] = __builtin_amdgcn_mfma_f32_32x32x16_bf16(kf[j & 1][d0], qf[d0], p[j], 0, 0, 0); }
#undef ATT_LDK
            if (n == 0) {
#pragma unroll
                for (int j = 0; j < 5; ++j) if (jt0 + j < 4) {
#pragma unroll
                    for (int r = 0; r < 16; ++r) p[j][r] = NEG; }
            }
            float mx = sink2;
#pragma unroll
            for (int j = 0; j < 5; ++j)
#pragma unroll
                for (int r = 0; r < 16; ++r) mx = fmaxf(mx, p[j][r]);
            mx = fmaxf(mx, shx(mx, 32, lane));
            float sum = 0.f;
#pragma unroll
            for (int j = 0; j < 5; ++j)
#pragma unroll
                for (int r = 0; r < 16; ++r) { const float e = __builtin_amdgcn_exp2f(p[j][r] - mx); p[j][r] = e; sum += e; }
            sum += shx(sum, 32, lane);
            sum += __builtin_amdgcn_exp2f(sink2 - mx);
            const float inv = 1.0f / sum;
            f32x16 o[2];
            s16x4 vlo[2][2], vh8[2][2];
            LAS unsigned char* vbase = lds + A_VOFF + (jt0 * 32 + 4 * hi + ((lane >> 2) & 3)) * 64 + ((lane >> 4) & 1) * 32 + (lane & 3) * 8;
#define ATT_LDV(buf, t_) do { _Pragma("unroll") for (int dh = 0; dh < 2; ++dh) { LAS unsigned char* va_ = vbase + dh * 16384 + (t_) * 1024; \
                vlo[buf][dh] = __builtin_bit_cast(s16x4, __builtin_amdgcn_ds_read_tr16_b64_v4i16((LAS s16x4*)va_)); vh8[buf][dh] = __builtin_bit_cast(s16x4, __builtin_amdgcn_ds_read_tr16_b64_v4i16((LAS s16x4*)(va_ + 512))); } } while (0)
            ATT_LDV(0, 0);
#pragma unroll
            for (int t = 0; t < 10; ++t) { const int j = t >> 1, s = t & 1;
                if (t < 9) ATT_LDV((t + 1) & 1, t + 1);
                u32x4 pw; pw.x = cvt_pk_bf16(p[j][8 * s + 0], p[j][8 * s + 1]); pw.y = cvt_pk_bf16(p[j][8 * s + 2], p[j][8 * s + 3]);
                pw.z = cvt_pk_bf16(p[j][8 * s + 4], p[j][8 * s + 5]); pw.w = cvt_pk_bf16(p[j][8 * s + 6], p[j][8 * s + 7]);
                const bf16x8 pf = __builtin_bit_cast(bf16x8, pw);
#pragma unroll
                for (int dh = 0; dh < 2; ++dh) { const s16x4 lo = vlo[t & 1][dh], h8 = vh8[t & 1][dh];
                    const bf16x8 vf = (bf16x8){lo[0], lo[1], lo[2], lo[3], h8[0], h8[1], h8[2], h8[3]};
                    const f32x16 zero16 = {0.f, 0.f, 0.f, 0.f, 0.f, 0.f, 0.f, 0.f, 0.f, 0.f, 0.f, 0.f, 0.f, 0.f, 0.f, 0.f};
                    o[dh] = __builtin_amdgcn_mfma_f32_32x32x16_bf16(vf, pf, t == 0 ? zero16 : o[dh], 0, 0, 0); } }
#undef ATT_LDV
            bf16_t* op = O + (size_t)(tok0 + r0 + r32) * D + head * 64 + 4 * hi;
#pragma unroll
            for (int dh = 0; dh < 2; ++dh)
#pragma unroll
                for (int gq = 0; gq < 4; ++gq) { u32x2 w; w.x = cvt_pk_bf16(o[dh][4 * gq] * inv, o[dh][4 * gq + 1] * inv); w.y = cvt_pk_bf16(o[dh][4 * gq + 2] * inv, o[dh][4 * gq + 3] * inv); *(GAS u32x2*)(op + 32 * dh + 8 * gq) = w; }
        }
        __syncthreads();
    }
}

#define XB_TMO      128
#define XB_XCNT(j)  (256  + 64 * (j))
#define XB_XSUB(j)  (1280 + 64 * (j))
#define XB_XGEN(j)  (2304 + 64 * (j))
#define XB_TOP      3328
#define XB_TOPGEN   3392
#define XCD_BAR_WORDS 3456
#define XB_SPIN_CAP (1u << 22)
__device__ __forceinline__ unsigned xb_ld(unsigned* p)              { return __hip_atomic_load(p, __ATOMIC_RELAXED, __HIP_MEMORY_SCOPE_AGENT); }
__device__ __forceinline__ unsigned xb_add(unsigned* p, unsigned v) { return __hip_atomic_fetch_add(p, v, __ATOMIC_RELAXED, __HIP_MEMORY_SCOPE_AGENT); }
__device__ __forceinline__ unsigned xb_xcc_id() { return (unsigned)__builtin_amdgcn_s_getreg((3 << 11) | 20) & 0xFu; }
#define XB_SPIN(cond, bar) do { unsigned _sp = 0; while (cond) { __builtin_amdgcn_s_sleep(1); \
    if ((++_sp & 255u) == 0u) { if (xb_ld(&(bar)[XB_TMO])) break; if (_sp > XB_SPIN_CAP) { atomicAdd(&(bar)[XB_TMO], 1u); break; } } } } while (0)
struct XcdBarrier { unsigned* bar; unsigned x; volatile LAS unsigned* st; };
__device__ __forceinline__ XcdBarrier xcd_barrier_post(unsigned* bar, volatile LAS unsigned* st) {
    XcdBarrier b; b.bar = bar; b.x = 0; b.st = st;
    if (threadIdx.x == 0) (void)xb_add(&bar[XB_XCNT(xb_xcc_id())], 1u);
    return b;
}
__device__ __forceinline__ void xcd_barrier_complete(unsigned* bar, unsigned x, unsigned& nloc, unsigned& nx) {
    const unsigned G = gridDim.x * gridDim.y * gridDim.z;
    unsigned sum, cnt, mine, sp = 0u;
    for (;;) {
        sum = 0u; cnt = 0u; mine = 0u;
#pragma unroll
        for (unsigned j = 0; j < 16; ++j) { const unsigned c = xb_ld(&bar[XB_XCNT(j)]); sum += c; cnt += (c > 0u) ? 1u : 0u; mine = (j == x) ? c : mine; }
        if (sum == G) break;
        __builtin_amdgcn_s_sleep(1);
        if ((++sp & 255u) == 0u) { if (xb_ld(&bar[XB_TMO])) break; if (sp > XB_SPIN_CAP) { atomicAdd(&bar[XB_TMO], 1u); break; } }
    }
    nloc = mine > 0u ? mine : 1u; nx = cnt > 0u ? cnt : 1u;
}
__device__ __forceinline__ void xcd_barrier(const XcdBarrier& b, int wave_s) {
    asm volatile("s_waitcnt vmcnt(0) lgkmcnt(0)" ::: "memory");
    __syncthreads();
    unsigned m1_ = ~0u; asm volatile("" : "+s"(m1_));
    if (wave_s == 0 && __builtin_amdgcn_mbcnt_hi(m1_, __builtin_amdgcn_mbcnt_lo(m1_, 0u)) == 0u) {
        unsigned* bar = b.bar; asm volatile("" : "+s"(bar)); const unsigned bx = xb_xcc_id();
        __builtin_amdgcn_s_waitcnt(0);
        unsigned nloc = b.st[0], nx = b.st[1];
        if (nloc == 0u) { xcd_barrier_complete(bar, bx, nloc, nx); b.st[0] = nloc; b.st[1] = nx; }
        const unsigned old = xb_add(&bar[XB_XSUB(bx)], 1u);
        const unsigned gen = old / nloc;
        if (old + 1u == (gen + 1u) * nloc) {
            __builtin_amdgcn_fence(__ATOMIC_RELEASE, "agent");
            asm volatile("s_waitcnt vmcnt(0)" ::: "memory");
            const unsigned og = xb_add(&bar[XB_TOP], 1u);
            const unsigned tg = og / nx;
            if (og + 1u == (tg + 1u) * nx) {
                xb_add(&bar[XB_TOPGEN], 1u); xb_add(&bar[XB_XGEN(bx)], 1u);
                __builtin_amdgcn_fence(__ATOMIC_ACQUIRE, "agent"); asm volatile("s_waitcnt vmcnt(0)" ::: "memory");
            } else {
                __builtin_amdgcn_fence(__ATOMIC_ACQUIRE, "agent"); asm volatile("s_waitcnt vmcnt(0)" ::: "memory");
                XB_SPIN(xb_ld(&bar[XB_TOPGEN]) == tg, bar);
                xb_add(&bar[XB_XGEN(bx)], 1u);
            }
        } else {
            __builtin_amdgcn_fence(__ATOMIC_ACQUIRE, "agent");
            asm volatile("s_waitcnt vmcnt(0)" ::: "memory");
            XB_SPIN(xb_ld(&bar[XB_XGEN(bx)]) == gen, bar);
        }
    }
    __syncthreads();
}
struct Ctx {
    int tid, lane, wave, G, gw, ngw, gtid, nthr;
    bf16_t *Wb, *HB, *MB, *ACT, *ATT, *KB, *VB, *PB, *PP; float *COS, *SIN, *PSSA, *PSSB; unsigned long long* XS;
};
__device__ __forceinline__ Ctx make_ctx(unsigned char* ws_in, int tid) {
    unsigned char* ws = (unsigned char*)(GAS unsigned char*)ws_in;
    Ctx c; c.tid = tid; c.lane = tid & 63; c.wave = __builtin_amdgcn_readfirstlane(tid >> 6); c.G = gridDim.x;
    c.gw = blockIdx.x * NWAVES + c.wave; c.ngw = c.G * NWAVES; c.gtid = blockIdx.x * NTHREADS + tid; c.nthr = c.G * NTHREADS;
    c.Wb = (bf16_t*)(ws + WS_W); c.HB = (bf16_t*)(ws + WS_HB); c.MB = (bf16_t*)(ws + WS_MB); c.ACT = (bf16_t*)(ws + WS_ACT); c.ATT = (bf16_t*)(ws + WS_ACT + 64 * MiB);
    c.KB = (bf16_t*)(ws + WS_K); c.VB = (bf16_t*)(ws + WS_V); c.PB = (bf16_t*)(ws + WS_PB);
    c.COS = (float*)(ws + WS_COS); c.SIN = (float*)(ws + WS_SIN); c.PSSA = (float*)(ws + WS_PSSA); c.PSSB = (float*)(ws + WS_PSSB); c.PP = (bf16_t*)(ws + WS_PP);
    c.XS = (unsigned long long*)(ws + WS_XS);
    return c;
}
#define GRID_SYNC() do { xcd_barrier(xbar, wave_s); } while (0)
#define PHASE_BEGIN() unsigned m1_ = ~0u; asm volatile("" : "+s"(m1_)); int tid_p = wave_s * 64 + (int)__builtin_amdgcn_mbcnt_hi(m1_, __builtin_amdgcn_mbcnt_lo(m1_, 0u)); asm volatile("" : "+s"(ws_s)); const Ctx C = make_ctx(ws_s, tid_p)
#define INP(k) ({ int kk_ = (k); asm volatile("" : "+s"(kk_)); (const float*)(GAS const float*)args.in[kk_]; })

__global__ void __launch_bounds__(NTHREADS, 2) mk_fwd(Args args) {
    extern __shared__ __attribute__((aligned(16))) unsigned char lds_raw[];
    LAS unsigned char* lds = (LAS unsigned char*)lds_raw;
    cg::grid_group grid = cg::this_grid();
    unsigned char* ws_s = args.ws;
    unsigned xuse = 0;
    int wave_s = __builtin_amdgcn_readfirstlane(threadIdx.x >> 6);
    volatile LAS unsigned* xst = (volatile LAS unsigned*)(lds + 131072 + 12288);
    if (threadIdx.x < 2) xst[threadIdx.x] = 0u;
    __syncthreads();
    const XcdBarrier xbar = xcd_barrier_post((unsigned*)(args.ws + WS_BAR), xst);
    if (__builtin_expect(args.ws == nullptr, 0)) grid.sync();
    float* H = (float*)(GAS float*)args.out;

    {
        PHASE_BEGIN();
        LAS float* scr = (LAS float*)(lds + C.wave * 16384);
        {
            int jn = 0, basen = 0, g = C.gw;
#define WC_LOCATE(found_) do { found_ = false; while (jn < NJOBS) { const int n_ = (args.jobs[jn].K / 64) * (args.jobs[jn].N / 32); if (g < basen + n_) { found_ = true; break; } basen += n_; ++jn; } } while (0)
            bool hc; WC_LOCATE(hc);
            float wa[32], ga[32], wb[32], gb[32];
            int jc = jn, ic = g - basen;
            if (hc) wconv_load(args.jobs[jc].W, args.jobs[jc].gk, args.jobs[jc].N, ic, C.lane, wa, ga);
            while (hc) {
                g += C.ngw; bool hn; WC_LOCATE(hn);
                const int jx = jn, ix = g - basen;
                if (hn) wconv_load(args.jobs[jx].W, args.jobs[jx].gk, args.jobs[jx].N, ix, C.lane, wb, gb);
                wconv_finish(args.jobs[jc].gn, args.jobs[jc].dst, args.jobs[jc].K, args.jobs[jc].N, args.jobs[jc].mode, args.jobs[jc].cs, scr, ic, C.lane, wa, ga);
#pragma unroll
                for (int i = 0; i < 32; ++i) { wa[i] = wb[i]; ga[i] = gb[i]; }
                jc = jx; ic = ix; hc = hn;
            }
#undef WC_LOCATE
        }
        for (int i = C.gtid; i < SEQ * 32; i += C.nthr) { const int pos = i >> 5, dd = i & 31;
            const float inv = __builtin_amdgcn_exp2f(-(float)dd * 0.41524101186092029f);
            const double rev = (double)pos * (double)inv * 0.15915494309189535; const float f = (float)(rev - __builtin_floor(rev));
            ((GAS float*)C.COS)[i] = __builtin_amdgcn_cosf(f); ((GAS float*)C.SIN)[i] = __builtin_amdgcn_sinf(f); }
        conv_p(INP(1), C.PB, C.gtid, C.nthr);
        __syncthreads();
        pool_prep<true>(INP(0), INP(2), C.ACT, lds, C.tid, C.wave, C.lane);
    }
    GRID_SYNC();

#pragma nounroll
    for (int L = 0; L < 4; ++L) {
        if (L < 2) {
            if (L == 1) { PHASE_BEGIN(); conv_p(INP(1) + (size_t)L * T * PLE, C.PB, C.gtid, C.nthr); pool_prep<false>(C.MB, INP(2) + L * D, C.ACT, lds, C.tid, C.wave, C.lane, C.PSSB); GRID_SYNC(); }
            { PHASE_BEGIN(); ++xuse; pg8::Gemm g{C.ACT, C.Wb + W_POOL + L * W_POOL_SZ, D, 256, 256}; pg8::StaticOrder S; S.init(T, D, C.G, blockIdx.x);
              if (L == 0) { pg8::EpiNorm<true> E{INP(0), C.HB, INP(3) + L * D, C.PSSA, C.XS, xuse}; pg8::gemm_phase(lds, g, S, E, C.tid); }
              else { pg8::EpiNorm<false> E{C.MB, C.HB, INP(3) + L * D, C.PSSA, C.XS, xuse}; pg8::gemm_phase(lds, g, S, E, C.tid); } }
            GRID_SYNC();
        } else {
            const int j = L - 2;
            { PHASE_BEGIN(); conv_p(INP(1) + (size_t)L * T * PLE, C.PB, C.gtid, C.nthr);
              pg8::Gemm g{C.MB, j == 0 ? C.Wb + W_QKV : C.Wb + W_Q3, D, D, 0}; pg8::StaticOrder S; S.init(T, j == 0 ? 1536 : D, C.G, blockIdx.x);
              pg8::EpiQKV E{C.ACT, C.KB, C.VB, C.COS, C.SIN, C.PSSB}; pg8::gemm_phase(lds, g, S, E, C.tid); }
            GRID_SYNC();
            { PHASE_BEGIN(); const float* sinks = INP(13) + j * 16;
              attn_phase(C.ACT, C.KB, C.VB, C.ATT, sinks, lds, C.G, C.tid, C.wave, C.lane); }
            GRID_SYNC();
            { PHASE_BEGIN(); ++xuse; pg8::Gemm g{C.ATT, C.Wb + W_O + (size_t)j * D * D, D, D, 0}; pg8::StaticOrder S; S.init(T, D, C.G, blockIdx.x);
              pg8::EpiNorm<false> E{C.MB, C.HB, INP(3) + L * D, C.PSSA, C.XS, xuse}; pg8::gemm_phase(lds, g, S, E, C.tid); }
            GRID_SYNC();
        }
        { PHASE_BEGIN(); pg8::Gemm g{C.HB, C.Wb + W_GU + L * W_GU_SZ, D, D, 0}; pg8::StaticOrder S; S.init(T, 2 * FF, C.G, blockIdx.x);
          pg8::EpiSwiglu E{C.ACT, C.PSSA}; pg8::gemm_phase(lds, g, S, E, C.tid); }
        { PHASE_BEGIN(); pg8::Gemm g{C.PB, C.Wb + W_PP + L * W_PP_SZ, PLE, PLE, 0}; pg8::StaticOrder S; S.init(T, D, C.G, blockIdx.x);
          pg8::EpiPlain E{C.PP, D, nullptr}; pg8::gemm_phase(lds, g, S, E, C.tid); }
        GRID_SYNC();
        { PHASE_BEGIN(); ++xuse; pg8::Gemm g{C.ACT, C.Wb + W_D + L * W_D_SZ, FF, FF, 0}; pg8::StaticOrder S; S.init(T, D, C.G, blockIdx.x);
          pg8::EpiNorm<false> E{C.HB, C.HB, INP(5) + L * D, C.PSSA, C.XS, xuse}; pg8::gemm_phase(lds, g, S, E, C.tid); }
        GRID_SYNC();
        { PHASE_BEGIN(); pg8::Gemm g{C.HB, C.Wb + W_PG + L * W_PG_SZ, D, D, 0}; pg8::StaticOrder S; S.init(T, D, C.G, blockIdx.x);
          if (L < 3) { pg8::EpiPle<false> E{C.HB, C.MB, H, C.PP, C.PSSA, C.PSSB}; pg8::gemm_phase(lds, g, S, E, C.tid); }
          else { pg8::EpiPle<true> E{C.HB, C.MB, H, C.PP, C.PSSA, C.PSSB}; pg8::gemm_phase(lds, g, S, E, C.tid); } }
        if (L < 3) GRID_SYNC();
    }
}

extern "C" void kernel_launch(void* const* d_in, const int* in_sizes, int n_in, void* d_out, int out_size, void* d_ws, size_t ws_size, hipStream_t stream) {
    static int grid = 0;
    if (grid == 0) {
        if (n_in != 20 || out_size != T * D || ws_size < WS_END) { fprintf(stderr, "kernel_launch: unexpected shapes (n_in %d out %d ws %zu)\n", n_in, out_size, ws_size); grid = -1; return; }
        int dev = 0, cus = 0, per_cu = 0;
        hipGetDevice(&dev); hipDeviceGetAttribute(&cus, hipDeviceAttributeMultiprocessorCount, dev);
        hipFuncSetAttribute((const void*)mk_fwd, hipFuncAttributeMaxDynamicSharedMemorySize, LDS_BYTES);
        if (hipOccupancyMaxActiveBlocksPerMultiprocessor(&per_cu, (const void*)mk_fwd, NTHREADS, LDS_BYTES) != hipSuccess || per_cu < 1) per_cu = 1;
        (void)hipGetLastError();
        grid = cus * per_cu;
    }
    if (grid < 0) return;
    Args a{};
    for (int i = 0; i < 20; ++i) a.in[i] = (const float*)d_in[i];
    a.out = (float*)d_out; a.ws = (unsigned char*)d_ws;
    bf16_t* Wb = (bf16_t*)((unsigned char*)d_ws + WS_W);
    const float *mix_pre_g = a.in[2], *ffn_pre_g = a.in[4], *pool_w = a.in[6], *pool_scale = a.in[7], *kv_norm_g = a.in[8], *w_k = a.in[9], *w_v = a.in[10], *w_q = a.in[11], *w_o = a.in[12];
    const float *w_gate = a.in[14], *w_up = a.in[15], *w_down = a.in[16], *ple_norm_g = a.in[17], *w_pleg = a.in[18], *w_plep = a.in[19];
    int nj = 0;
    auto add = [&](const float* W, const float* gk, const float* gn, bf16_t* dst, int K, int N, int mode, float cs) { Job& J = a.jobs[nj++]; J.W = W; J.gk = gk; J.gn = gn; J.dst = dst; J.K = K; J.N = N; J.mode = mode; J.cs = cs; };
    for (int i = 0; i < 4; ++i) {
        add(w_gate + (size_t)i * D * FF, ffn_pre_g + i * D, nullptr, Wb + W_GU + i * W_GU_SZ, D, FF, 1, 1.f);
        add(w_up + (size_t)i * D * FF, ffn_pre_g + i * D, nullptr, Wb + W_GU + i * W_GU_SZ, D, FF, 2, 1.f);
        add(w_down + (size_t)i * FF * D, nullptr, nullptr, Wb + W_D + i * W_D_SZ, FF, D, 0, 1.f);
        add(w_pleg + (size_t)i * D * D, ple_norm_g + i * D, nullptr, Wb + W_PG + i * W_PG_SZ, D, D, 0, 1.f);
        add(w_plep + (size_t)i * PLE * D, nullptr, nullptr, Wb + W_PP + i * W_PP_SZ, PLE, D, 0, 1.f);
    }
    for (int i = 0; i < 2; ++i) for (int g = 0; g < 4; ++g)
        add(pool_w + ((size_t)i * 4 + g) * 256 * 256, nullptr, pool_scale + i * D + g * 256, Wb + W_POOL + i * W_POOL_SZ + (size_t)g * 256 * 256, 256, 256, 0, 1.f);
    add(w_q, mix_pre_g + 2 * D, nullptr, Wb + W_QKV, D, D, 3, C2);
    add(w_k, kv_norm_g, nullptr, Wb + W_QKV + (size_t)1024 * D, D, 256, 3, 1.f);
    add(w_v, kv_norm_g, nullptr, Wb + W_QKV + (size_t)1280 * D, D, 256, 0, 1.f);
    add(w_q + (size_t)D * D, mix_pre_g + 3 * D, nullptr, Wb + W_Q3, D, D, 3, C2);
    add(w_o, nullptr, nullptr, Wb + W_O, D, D, 0, 1.f);
    add(w_o + (size_t)D * D, nullptr, nullptr, Wb + W_O + (size_t)D * D, D, D, 0, 1.f);
    (void)hipMemsetAsync((unsigned char*)d_ws + WS_BAR, 0, BAR_ZERO_BYTES, stream);
    void* kargs[] = {&a};
    hipError_t e = hipLaunchCooperativeKernel((const void*)mk_fwd, dim3(grid), dim3(NTHREADS), kargs, LDS_BYTES, stream);
    if (e != hipSuccess) fprintf(stderr, "cooperative launch failed: %s (grid %d)\n", hipGetErrorString(e), grid);
}
```
